# Optimizing an MI355X kernel written in HIP

```python
import jax, jax.numpy as jnp
from jax import lax
import numpy as np

D_MODEL = 1024
BATCH = 8
SEQ = 2048
DEPTH = 1
DEC_BATCH = 128
DEC_SEQ = 1
PAST_LEN = 16384
PAGE_SIZE = 128

D_MIX = D_MODEL
D_S5 = D_MIX // 2
S5_GROUP = 16
S5_N_GROUPS = D_S5 // S5_GROUP
S5_STATE = 64
D_GDN = D_MIX - D_S5
GDN_HEAD_DIM = 128
GDN_HEADS = D_GDN // GDN_HEAD_DIM
GDN_CONV = 4
GDN_CHUNK = 64
D_FF = 2816
FFN_CONV = 3
NORM_EPS = 1e-6
D_IN = D_S5 + 4 * D_GDN + 2 * GDN_HEADS

kernel_name = 'hymba_s5_gdn_convffn_step'


def rmsnorm(x, g):
    xf = x.astype(jnp.float32)
    xf = xf * lax.rsqrt(jnp.mean(xf * xf, axis=-1, keepdims=True) + NORM_EPS)
    return (xf * g.astype(jnp.float32)).astype(x.dtype)


def l2norm(x):
    xf = x.astype(jnp.float32)
    return xf * lax.rsqrt(jnp.sum(xf * xf, axis=-1, keepdims=True) + NORM_EPS)


def causal_depthwise_conv(x, buf, w):
    width = w.shape[0]
    seq = x.shape[1]
    xp = jnp.concatenate([buf.astype(x.dtype), x], axis=1)
    y = xp[:, 0:seq] * w[0]
    for j in range(1, width):
        y = y + xp[:, j:j + seq] * w[j]
    return y, xp[:, seq:]


def s5_mixer(u, h0_re, h0_im, a_re, a_im, log_dt, b_re, b_im, c_re, c_im, d, w_glu):
    bsz, seq, _ = u.shape
    uf = u.astype(jnp.float32)
    ug = uf.reshape(bsz, seq, S5_N_GROUPS, S5_GROUP)
    ar = a_re.astype(jnp.float32)
    ai = a_im.astype(jnp.float32)
    dt = jnp.exp(log_dt.astype(jnp.float32))[:, None]
    mag = jnp.exp(ar * dt)
    ab_re = mag * jnp.cos(ai * dt)
    ab_im = mag * jnp.sin(ai * dt)
    den = ar * ar + ai * ai
    p = ab_re - 1.0
    f_re = (p * ar + ab_im * ai) / den
    f_im = (ab_im * ar - p * ai) / den
    bu_re = jnp.einsum('bsgc,gnc->bsgn', ug, b_re.astype(jnp.float32))
    bu_im = jnp.einsum('bsgc,gnc->bsgn', ug, b_im.astype(jnp.float32))
    x_re = f_re * bu_re - f_im * bu_im
    x_im = f_re * bu_im + f_im * bu_re
    h0r = h0_re.astype(jnp.float32)
    h0i = h0_im.astype(jnp.float32)
    x_re = x_re.at[:, 0].add(ab_re * h0r - ab_im * h0i)
    x_im = x_im.at[:, 0].add(ab_re * h0i + ab_im * h0r)
    a_full_re = jnp.broadcast_to(ab_re, x_re.shape)
    a_full_im = jnp.broadcast_to(ab_im, x_im.shape)

    def combine(e1, e2):
        a1r, a1i, b1r, b1i = e1
        a2r, a2i, b2r, b2i = e2
        return (a2r * a1r - a2i * a1i, a2r * a1i + a2i * a1r,
                a2r * b1r - a2i * b1i + b2r, a2r * b1i + a2i * b1r + b2i)

    _, _, h_re, h_im = lax.associative_scan(combine, (a_full_re, a_full_im, x_re, x_im), axis=1)
    y = (jnp.einsum('bsgn,gcn->bsgc', h_re, c_re.astype(jnp.float32))
         - jnp.einsum('bsgn,gcn->bsgc', h_im, c_im.astype(jnp.float32)))
    y = y.reshape(bsz, seq, D_S5) + d.astype(jnp.float32) * uf
    y = jax.nn.gelu(y)
    gl = y @ w_glu.astype(jnp.float32)
    out = gl[..., :D_S5] * jax.nn.sigmoid(gl[..., D_S5:])
    return out.astype(u.dtype), h_re[:, -1], h_im[:, -1]


def gdn_chunked(q, k, v, g, beta, s0):
    bsz, seq = q.shape[0], q.shape[1]
    nc = -(-seq // GDN_CHUNK)
    pad = nc * GDN_CHUNK - seq

    def prep(t):
        t = jnp.pad(t.astype(jnp.float32), [(0, 0), (0, pad)] + [(0, 0)] * (t.ndim - 2))
        t = t.reshape((bsz, nc, GDN_CHUNK) + t.shape[2:])
        return jnp.moveaxis(t, 3, 1)

    q, k, v, g, beta = prep(q), prep(k), prep(v), prep(g), prep(beta)
    dv = v.shape[-1]
    gc = jnp.cumsum(g, axis=-1)
    idx = jnp.arange(GDN_CHUNK)
    causal = idx[:, None] >= idx[None, :]
    strict = idx[:, None] > idx[None, :]
    decay = jnp.exp(jnp.where(causal, gc[..., :, None] - gc[..., None, :], -jnp.inf))
    kb = k * beta[..., None]
    vb = v * beta[..., None]
    lmat = jnp.where(strict, jnp.einsum('bhnid,bhnjd->bhnij', kb, k) * decay, 0.0)
    eye = jnp.eye(GDN_CHUNK, dtype=jnp.float32)
    rhs = jnp.concatenate([vb, kb * jnp.exp(gc)[..., None]], axis=-1)
    sol = lax.linalg.triangular_solve(eye + lmat, rhs, left_side=True, lower=True)
    u_c, w_c = sol[..., :dv], sol[..., dv:]
    attn = jnp.einsum('bhnid,bhnjd->bhnij', q, k) * decay
    qg = q * jnp.exp(gc)[..., None]
    kg = k * jnp.exp(gc[..., -1:] - gc)[..., None]
    glast = jnp.exp(gc[..., -1])
    xs = tuple(jnp.moveaxis(t, 2, 0) for t in (u_c, w_c, attn, qg, kg, glast))

    def step(s, inp):
        uu, ww, aa, qq, kk, gl = inp
        v_new = uu - jnp.einsum('bhcd,bhde->bhce', ww, s)
        o = jnp.einsum('bhcd,bhde->bhce', qq, s) + jnp.einsum('bhij,bhje->bhie', aa, v_new)
        s = s * gl[..., None, None] + jnp.einsum('bhcd,bhce->bhde', kk, v_new)
        return s, o

    s_fin, o = lax.scan(step, s0.astype(jnp.float32), xs)
    o = o.transpose(1, 0, 3, 2, 4).reshape(bsz, nc * GDN_CHUNK, GDN_HEADS, dv)[:, :seq]
    return o, s_fin


def gdn_mixer(qkv, z, beta_raw, a_raw, s0, conv_buf, conv_w, a_log, dt_bias, onorm_g):
    bsz, seq, _ = qkv.shape
    qkv_c, new_buf = causal_depthwise_conv(qkv, conv_buf, conv_w)
    qkv_c = jax.nn.silu(qkv_c)
    q = qkv_c[..., :D_GDN].reshape(bsz, seq, GDN_HEADS, GDN_HEAD_DIM)
    k = qkv_c[..., D_GDN:2 * D_GDN].reshape(bsz, seq, GDN_HEADS, GDN_HEAD_DIM)
    v = qkv_c[..., 2 * D_GDN:].reshape(bsz, seq, GDN_HEADS, GDN_HEAD_DIM)
    q = l2norm(q) * (GDN_HEAD_DIM ** -0.5)
    k = l2norm(k)
    beta = jax.nn.sigmoid(beta_raw.astype(jnp.float32))
    g = -jnp.exp(a_log.astype(jnp.float32)) * jax.nn.softplus(a_raw.astype(jnp.float32) + dt_bias.astype(jnp.float32))
    o, s_fin = gdn_chunked(q, k, v, g, beta, s0)
    zf = z.reshape(bsz, seq, GDN_HEADS, GDN_HEAD_DIM).astype(jnp.float32)
    o = rmsnorm(o, onorm_g) * jax.nn.silu(zf)
    return o.reshape(bsz, seq, D_GDN).astype(qkv.dtype), s_fin, new_buf


def conv_ffn(x, buf, w_up, conv_w, w_down):
    h = x @ w_up
    h, new_buf = causal_depthwise_conv(h, buf, conv_w)
    gate, up = h[..., :D_FF], h[..., D_FF:]
    return (jax.nn.silu(gate) * up) @ w_down, new_buf


def layer(x, s5_re, s5_im, gdn_s, gdn_buf, ffn_buf, norm1_g, w_in, s5_a_re, s5_a_im, s5_log_dt,
          s5_b_re, s5_b_im, s5_c_re, s5_c_im, s5_d, s5_w_glu, gdn_conv_w, gdn_a_log, gdn_dt_bias,
          gdn_onorm_g, w_out, norm2_g, ffn_w_up, ffn_conv_w, ffn_w_down):
    n = rmsnorm(x, norm1_g)
    proj = n @ w_in
    o0 = D_S5
    u_s5 = proj[..., :o0]
    qkv = proj[..., o0:o0 + 3 * D_GDN]
    z = proj[..., o0 + 3 * D_GDN:o0 + 4 * D_GDN]
    beta_raw = proj[..., o0 + 4 * D_GDN:o0 + 4 * D_GDN + GDN_HEADS]
    a_raw = proj[..., o0 + 4 * D_GDN + GDN_HEADS:]
    y_s5, s5_re, s5_im = s5_mixer(u_s5, s5_re, s5_im, s5_a_re, s5_a_im, s5_log_dt,
                                  s5_b_re, s5_b_im, s5_c_re, s5_c_im, s5_d, s5_w_glu)
    y_gdn, gdn_s, gdn_buf = gdn_mixer(qkv, z, beta_raw, a_raw, gdn_s, gdn_buf, gdn_conv_w,
                                      gdn_a_log, gdn_dt_bias, gdn_onorm_g)
    x = x + jnp.concatenate([y_s5, y_gdn], axis=-1) @ w_out
    y_ffn, ffn_buf = conv_ffn(rmsnorm(x, norm2_g), ffn_buf, ffn_w_up, ffn_conv_w, ffn_w_down)
    x = x + y_ffn
    return x, s5_re, s5_im, gdn_s, gdn_buf, ffn_buf


def setup_inputs(seed: int = 0) -> dict:
    key = jax.random.key(seed)
    ks = jax.random.split(key, 32)
    f32 = jnp.float32
    nrm = lambda k, shape, s: jax.random.normal(k, shape, f32) * s
    G, N = S5_N_GROUPS, S5_STATE
    a_im_base = jnp.pi * jnp.arange(N, dtype=f32)
    dt_g = jnp.exp(jax.random.uniform(ks[20], (DEPTH, GDN_HEADS), f32, np.log(1e-3), np.log(1e-1)))
    return {
        'x_prompt': nrm(ks[0], (BATCH, SEQ, D_MODEL), 1.0),
        'x_sample': nrm(ks[1], (DEC_BATCH, DEC_SEQ, D_MODEL), 1.0),
        'state_s5_re': nrm(ks[2], (DEPTH, DEC_BATCH, G, N), 0.5),
        'state_s5_im': nrm(ks[3], (DEPTH, DEC_BATCH, G, N), 0.5),
        'state_gdn': nrm(ks[4], (DEPTH, DEC_BATCH, GDN_HEADS, GDN_HEAD_DIM, GDN_HEAD_DIM), 0.3),
        'state_gdn_conv': nrm(ks[5], (DEPTH, DEC_BATCH, GDN_CONV - 1, 3 * D_GDN), 1.0),
        'state_ffn_conv': nrm(ks[6], (DEPTH, DEC_BATCH, FFN_CONV - 1, 2 * D_FF), 1.0),
        'norm1_g': 1.0 + nrm(ks[7], (DEPTH, D_MODEL), 0.02),
        'w_in': nrm(ks[8], (DEPTH, D_MODEL, D_IN), D_MODEL ** -0.5),
        's5_a_re': -0.5 + nrm(ks[9], (DEPTH, G, N), 0.01),
        's5_a_im': a_im_base + nrm(ks[10], (DEPTH, G, N), 0.01),
        's5_log_dt': jax.random.uniform(ks[11], (DEPTH, G), f32, np.log(1e-3), np.log(1e-1)),
        's5_b_re': nrm(ks[12], (DEPTH, G, N, S5_GROUP), (2 * S5_GROUP) ** -0.5),
        's5_b_im': nrm(ks[13], (DEPTH, G, N, S5_GROUP), (2 * S5_GROUP) ** -0.5),
        's5_c_re': nrm(ks[14], (DEPTH, G, S5_GROUP, N), N ** -0.5),
        's5_c_im': nrm(ks[15], (DEPTH, G, S5_GROUP, N), N ** -0.5),
        's5_d': nrm(ks[16], (DEPTH, D_S5), 0.5),
        's5_w_glu': nrm(ks[17], (DEPTH, D_S5, 2 * D_S5), D_S5 ** -0.5),
        'gdn_conv_w': nrm(ks[18], (DEPTH, GDN_CONV, 3 * D_GDN), GDN_CONV ** -0.5),
        'gdn_a_log': jnp.log(jax.random.uniform(ks[19], (DEPTH, GDN_HEADS), f32, 1.0, 16.0)),
        'gdn_dt_bias': dt_g + jnp.log(-jnp.expm1(-dt_g)),
        'gdn_onorm_g': 1.0 + nrm(ks[21], (DEPTH, GDN_HEAD_DIM), 0.02),
        'w_out': nrm(ks[22], (DEPTH, D_MIX, D_MODEL), D_MIX ** -0.5),
        'norm2_g': 1.0 + nrm(ks[23], (DEPTH, D_MODEL), 0.02),
        'ffn_w_up': nrm(ks[24], (DEPTH, D_MODEL, 2 * D_FF), D_MODEL ** -0.5),
        'ffn_conv_w': nrm(ks[25], (DEPTH, FFN_CONV, 2 * D_FF), FFN_CONV ** -0.5),
        'ffn_w_down': nrm(ks[26], (DEPTH, D_FF, D_MODEL), D_FF ** -0.5),
        'normf_g': 1.0 + nrm(ks[27], (D_MODEL,), 0.02),
    }


def reference(x_prompt, x_sample, state_s5_re, state_s5_im, state_gdn, state_gdn_conv, state_ffn_conv,
              norm1_g, w_in, s5_a_re, s5_a_im, s5_log_dt, s5_b_re, s5_b_im, s5_c_re, s5_c_im, s5_d,
              s5_w_glu, gdn_conv_w, gdn_a_log, gdn_dt_bias, gdn_onorm_g, w_out, norm2_g, ffn_w_up,
              ffn_conv_w, ffn_w_down, normf_g):
    f32 = jnp.float32
    xp, xs = x_prompt, x_sample
    p_new = ([], [], [], [], [])
    s_new = ([], [], [], [], [])
    for l in range(DEPTH):
        lw = (norm1_g[l], w_in[l], s5_a_re[l], s5_a_im[l], s5_log_dt[l], s5_b_re[l], s5_b_im[l],
              s5_c_re[l], s5_c_im[l], s5_d[l], s5_w_glu[l], gdn_conv_w[l], gdn_a_log[l], gdn_dt_bias[l],
              gdn_onorm_g[l], w_out[l], norm2_g[l], ffn_w_up[l], ffn_conv_w[l], ffn_w_down[l])
        outp = layer(xp,
                     jnp.zeros((BATCH, S5_N_GROUPS, S5_STATE), f32),
                     jnp.zeros((BATCH, S5_N_GROUPS, S5_STATE), f32),
                     jnp.zeros((BATCH, GDN_HEADS, GDN_HEAD_DIM, GDN_HEAD_DIM), f32),
                     jnp.zeros((BATCH, GDN_CONV - 1, 3 * D_GDN), xp.dtype),
                     jnp.zeros((BATCH, FFN_CONV - 1, 2 * D_FF), xp.dtype),
                     *lw)
        outs = layer(xs, state_s5_re[l], state_s5_im[l], state_gdn[l], state_gdn_conv[l],
                     state_ffn_conv[l], *lw)
        xp, xs = outp[0], outs[0]
        for i in range(5):
            p_new[i].append(outp[i + 1])
            s_new[i].append(outs[i + 1])
    y_prompt = rmsnorm(xp, normf_g)
    y_sample = rmsnorm(xs, normf_g)
    p_s5_re, p_s5_im, p_gdn, p_gdn_conv, p_ffn_conv = [jnp.stack(t, axis=0) for t in p_new]
    s_s5_re, s_s5_im, s_gdn, s_gdn_conv, s_ffn_conv = [jnp.stack(t, axis=0) for t in s_new]
    return (y_prompt, y_sample, p_s5_re, p_s5_im, p_gdn, p_gdn_conv, p_ffn_conv,
            s_s5_re, s_s5_im, s_gdn, s_gdn_conv, s_ffn_conv)
```

```cpp
#include <hip/hip_runtime.h>
#include <hip/hip_cooperative_groups.h>
#include <cstdio>
namespace cg = cooperative_groups;

#ifndef MK_MULTI
#define MK_MULTI 0
#endif

typedef unsigned short bf16_t;
using bf16x8 = __attribute__((ext_vector_type(8))) short;
using f32x4 = __attribute__((ext_vector_type(4))) float;
using u32x4 = __attribute__((ext_vector_type(4))) unsigned;

#define DI __device__ __forceinline__

typedef __bf16 bf16x2_t __attribute__((ext_vector_type(2)));
typedef float f32x2_t __attribute__((ext_vector_type(2)));
DI bf16_t f2bf(float x) { __bf16 h = (__bf16)x; return __builtin_bit_cast(bf16_t, h); }
DI float bf2f(bf16_t b) { return __uint_as_float(((unsigned)b) << 16); }
DI unsigned pack2(float a, float b) { f32x2_t v = {a, b}; bf16x2_t r = __builtin_convertvector(v, bf16x2_t); return __builtin_bit_cast(unsigned, r); }
DI float bflo(unsigned u) { return __uint_as_float(u << 16); }
DI float bfhi(unsigned u) { return __uint_as_float(u & 0xffff0000u); }
DI float sigmoidf_(float x) { return 1.f / (1.f + __expf(-x)); }
DI float siluf_(float x) { return x / (1.f + __expf(-x)); }
DI float geluf_(float x) { float u = 0.7978845608028654f * (x + 0.044715f * x * x * x); float th = 1.f - 2.f / (1.f + __expf(2.f * u)); return 0.5f * x * (1.f + th); }
DI float wave_sum(float v) { for (int o = 32; o > 0; o >>= 1) v += __shfl_xor(v, o); return v; }
DI f32x4 mfma16(bf16x8 a, bf16x8 b, f32x4 c) { return __builtin_amdgcn_mfma_f32_16x16x32_bf16(a, b, c, 0, 0, 0); }

constexpr int NTOK = 16384;
constexpr int MROWS = 16512;
constexpr int NPROJ = 2560;
constexpr int SMEM_BYTES = 57344;

struct Params {
  const float *x_prompt, *x_sample, *st_s5_re, *st_s5_im, *st_gdn, *st_gdn_conv, *st_ffn_conv;
  const float *norm1_g, *w_in, *a_re, *a_im, *log_dt, *b_re, *b_im, *c_re, *c_im, *s5_d, *w_glu;
  const float *gdn_conv_w, *a_log, *dt_bias, *onorm_g, *w_out, *norm2_g, *w_up, *ffn_conv_w, *w_down, *normf_g;
  float *out;
  float *p_s5_re, *p_s5_im, *p_gdn, *p_gdn_conv, *p_ffn_conv, *s_s5_re, *s_s5_im, *s_gdn, *s_gdn_conv, *s_ffn_conv;
  float *ogdn;
  bf16_t *ys5;
  int *ctr; unsigned *bar; float *ba; float *glast; float *sproj;
  bf16_t *WinT, *WgluT, *WoutT, *WupT, *WdnT, *XN, *PROJ, *GDNI, *ACT;
};

DI const float* xin_row(const Params& p, int row) {
  return row < NTOK ? p.x_prompt + (size_t)row * 1024 : p.x_sample + (size_t)(row - NTOK) * 1024;
}

__shared__ int s_item;
DI int fetch_item(int* ctr) {
  __syncthreads();
  if (threadIdx.x == 0) s_item = atomicAdd(ctr, 1);
  __syncthreads();
  return s_item;
}

DI void lds_barrier() { asm volatile("s_waitcnt lgkmcnt(0)\n\ts_barrier" ::: "memory"); }

DI float block_sum(float v, float* red) {
  v = wave_sum(v);
  __syncthreads();
  if ((threadIdx.x & 63) == 0) red[threadIdx.x >> 6] = v;
  __syncthreads();
  return red[0] + red[1] + red[2] + red[3];
}

DI void transpose_item(const float* src, int ldsrc, int srccol0, int k0, bf16_t* dst, int lddst, int r0, float* tl) {
  const int t = threadIdx.x;
  float v[4][8];
  { const int jj = t & 31, kk = t >> 5;
#pragma unroll
    for (int kb = 0; kb < 4; ++kb)
#pragma unroll
      for (int i = 0; i < 8; ++i) v[kb][i] = src[(size_t)(k0 + kb * 64 + kk + 8 * i) * ldsrc + srccol0 + jj]; }
#pragma unroll
  for (int kb = 0; kb < 4; ++kb) {
    { const int jj = t & 31, kk = t >> 5;
#pragma unroll
      for (int i = 0; i < 8; ++i) tl[(kk + 8 * i) * 33 + jj] = v[kb][i]; }
    __syncthreads();
    { const int kk = t & 63, jj = t >> 6;
#pragma unroll
      for (int i = 0; i < 8; ++i) dst[(size_t)(r0 + jj + 4 * i) * lddst + k0 + kb * 64 + kk] = f2bf(tl[kk * 33 + jj + 4 * i]); }
    __syncthreads();
  }
}

DI int perm_col(int r0, int halfoff) {
  const int tt = r0 >> 7, rr = r0 & 127, wn = rr >> 6, half = (rr >> 5) & 1;
  return half * halfoff + tt * 64 + wn * 32;
}

__device__ void phase0(const Params& p, char* smem) {
  float* wt = (float*)smem;
  float* tl = (float*)(smem + 32768);
  for (int i = threadIdx.x; i < 8192; i += 256) { const int k = i >> 3, j = i & 7; wt[j * 1024 + k] = p.w_in[(size_t)k * 2568 + 2560 + j]; }
  __syncthreads();
  for (int i = blockIdx.x * 256 + threadIdx.x; i < 128 * NPROJ / 4; i += gridDim.x * 256) *(float4*)(p.sproj + (size_t)i * 4) = make_float4(0.f, 0.f, 0.f, 0.f);
  constexpr int NT_IN = 320, NT_GLU = 64, NT_OUT = 128, NT_UP = 704, NT_DN = 352;
  constexpr int nT = NT_IN + NT_GLU + NT_OUT + NT_UP + NT_DN;
  constexpr int nRow = MROWS / 8;
  for (int it = blockIdx.x; it < nT + nRow; it += gridDim.x) {
    if (it < nT) {
      int i = it;
      if (i < NT_IN) { const int r0 = (i >> 2) * 32, k0 = (i & 3) * 256; transpose_item(p.w_in, 2568, r0, k0, p.WinT, 1024, r0, tl); continue; }
      i -= NT_IN;
      if (i < NT_GLU) { const int r0 = (i >> 1) * 32, k0 = (i & 1) * 256; transpose_item(p.w_glu, 1024, perm_col(r0, 512), k0, p.WgluT, 512, r0, tl); continue; }
      i -= NT_GLU;
      if (i < NT_OUT) { const int r0 = (i >> 2) * 32, k0 = (i & 3) * 256; transpose_item(p.w_out, 1024, r0, k0, p.WoutT, 1024, r0, tl); continue; }
      i -= NT_OUT;
      if (i < NT_UP) { const int r0 = (i >> 2) * 32, k0 = (i & 3) * 256; transpose_item(p.w_up, 5632, perm_col(r0, 2816), k0, p.WupT, 1024, r0, tl); continue; }
      i -= NT_UP;
      { const int r0 = (i / 11) * 32, k0 = (i % 11) * 256; transpose_item(p.w_down, 1024, r0, k0, p.WdnT, 2816, r0, tl); }
    } else {
      const int lane = threadIdx.x & 63, w = threadIdx.x >> 6;
      float4 v2[2][4];
#pragma unroll
      for (int rr = 0; rr < 2; ++rr) {
        const float* xr = xin_row(p, (it - nT) * 8 + rr * 4 + w);
#pragma unroll
        for (int i = 0; i < 4; ++i) v2[rr][i] = *(const float4*)(xr + i * 256 + lane * 4);
      }
#pragma unroll
      for (int rr = 0; rr < 2; ++rr) {
        const int row = (it - nT) * 8 + rr * 4 + w;
        float4 v[4]; float ss = 0.f;
#pragma unroll
        for (int i = 0; i < 4; ++i) { v[i] = v2[rr][i]; ss += v[i].x * v[i].x + v[i].y * v[i].y + v[i].z * v[i].z + v[i].w * v[i].w; }
        ss = wave_sum(ss);
        const float rstd = rsqrtf(ss * (1.f / 1024.f) + 1e-6f);
        float acc[8];
#pragma unroll
        for (int j = 0; j < 8; ++j) acc[j] = 0.f;
#pragma unroll
        for (int i = 0; i < 4; ++i) {
          const float4 g = *(const float4*)(p.norm1_g + i * 256 + lane * 4);
          v[i].x *= rstd * g.x; v[i].y *= rstd * g.y; v[i].z *= rstd * g.z; v[i].w *= rstd * g.w;
          uint2 pk; pk.x = pack2(v[i].x, v[i].y); pk.y = pack2(v[i].z, v[i].w);
          *(uint2*)(p.XN + (size_t)row * 1024 + i * 256 + lane * 4) = pk;
#pragma unroll
          for (int j = 0; j < 8; ++j) { const float4 wv = *(const float4*)(wt + j * 1024 + i * 256 + lane * 4); acc[j] += v[i].x * wv.x + v[i].y * wv.y + v[i].z * wv.z + v[i].w * wv.w; }
        }
#pragma unroll
        for (int j = 0; j < 8; ++j) acc[j] = wave_sum(acc[j]);
        if (lane == 0) {
          *(float4*)(p.ba + (size_t)row * 8) = make_float4(acc[0], acc[1], acc[2], acc[3]);
          *(float4*)(p.ba + (size_t)row * 8 + 4) = make_float4(acc[4], acc[5], acc[6], acc[7]);
        }
      }
    }
  }
}

template <bool NULLCHK, int PMODE = 0>
DI void gemm_main(const bf16_t* a0, size_t astr, unsigned amask, const bf16_t* b0, size_t bstr, int nk, f32x4 (&acc)[4][4], char* smem) {
  char* As = smem;
  char* Bs = smem + 16384;
  const int t = threadIdx.x, lane = t & 63, w = t >> 6, wm = w >> 1, wn = w & 1, r = lane & 15, q = lane >> 4;
  const u32x4 z4 = u32x4{0u, 0u, 0u, 0u};
  u32x4 ra0[4], rb0[4];
  const int soff = (t >> 3) * 128 + (((t & 7) ^ ((t >> 3) & 7)) * 16);
  const int aoff = (wm * 64 + r) * 128, boff = (wn * 64 + r) * 128;
  const int sw0 = ((q) ^ (r & 7)) * 16, sw1 = ((4 + q) ^ (r & 7)) * 16;
#define G_LOAD(RA, RB, KT) _Pragma("unroll") for (int i = 0; i < 4; ++i) { \
    RA[i] = (!NULLCHK || ((amask >> i) & 1u)) ? *(const u32x4*)(a0 + i * astr + (KT) * 64) : z4; \
    RB[i] = *(const u32x4*)(b0 + i * bstr + (KT) * 64); }
#define G_STORE(RA, RB) _Pragma("unroll") for (int i = 0; i < 4; ++i) { \
    *(u32x4*)(As + soff + i * 4096) = RA[i]; \
    *(u32x4*)(Bs + soff + i * 4096) = RB[i]; }
#define G_COMPUTE() _Pragma("unroll") for (int ks = 0; ks < 2; ++ks) { \
    bf16x8 af[4], bfr[4]; \
    _Pragma("unroll") for (int mi = 0; mi < 4; ++mi) af[mi] = *(const bf16x8*)(As + aoff + mi * 2048 + (ks ? sw1 : sw0)); \
    _Pragma("unroll") for (int ni = 0; ni < 4; ++ni) bfr[ni] = *(const bf16x8*)(Bs + boff + ni * 2048 + (ks ? sw1 : sw0)); \
    __builtin_amdgcn_s_setprio(1); \
    _Pragma("unroll") for (int mi = 0; mi < 4; ++mi) _Pragma("unroll") for (int ni = 0; ni < 4; ++ni) acc[mi][ni] = mfma16(bfr[ni], af[mi], acc[mi][ni]); \
    __builtin_amdgcn_s_setprio(0); }
  G_LOAD(ra0, rb0, 0)
#pragma unroll
  for (int mi = 0; mi < 4; ++mi)
#pragma unroll
    for (int ni = 0; ni < 4; ++ni) acc[mi][ni] = f32x4{0.f, 0.f, 0.f, 0.f};
  for (int kt = 0; kt < nk; ++kt) {
    if (kt == 0) __syncthreads(); else lds_barrier();
    G_STORE(ra0, rb0)
    lds_barrier();
    if (PMODE != 1 && kt + 1 < nk) { G_LOAD(ra0, rb0, kt + 1) }
    __builtin_amdgcn_sched_barrier(0);
    G_COMPUTE()
  }
#undef G_LOAD
#undef G_STORE
#undef G_COMPUTE
}

template <int PMODE = 0>
DI void gemm_std(const bf16_t* A, int lda, int m0, const bf16_t* Bt, int ldb, int n0, int nk, f32x4 (&acc)[4][4], char* smem) {
  const int t = threadIdx.x;
  const bf16_t* a0 = A + (size_t)(m0 + (t >> 3)) * lda + (t & 7) * 8;
  const bf16_t* b0 = Bt + (size_t)(n0 + (t >> 3)) * ldb + (t & 7) * 8;
  gemm_main<false, PMODE>(a0, (size_t)32 * lda, 0xfu, b0, (size_t)32 * ldb, nk, acc, smem);
}

DI bool get_tile(int vb, int step, int MT, int NT, int GW, int& mt, int& nt, bool& valid) {
  const int G = gridDim.x;
  if ((G & 7) == 0 && ((G >> 3) % GW) == 0) {
    const int xcd = vb & 7, local = vb >> 3, GH = (G >> 3) / GW;
    const int NGN = (NT + GW - 1) / GW, NGM = (MT + GH - 1) / GH;
    const int g = step * 8 + xcd;
    if (g >= NGN * NGM) return false;
    mt = (g / NGN) * GH + local / GW; nt = (g % NGN) * GW + local % GW;
    valid = mt < MT && nt < NT;
    return true;
  }
  const int idx = vb + step * G;
  if (idx >= MT * NT) return false;
  mt = idx / NT; nt = idx % NT; valid = true;
  return true;
}

DI bool get_tile_strip(int vb, int step, int MT, int NT, int GW, int& mt, int& nt) {
  const int G = gridDim.x, T = MT * NT;
  int idx;
  if ((G & 7) == 0) {
    const int xcd = vb & 7, local = vb >> 3, lpx = G >> 3;
    const int start = (int)(((long)T * xcd) >> 3), end = (int)(((long)T * (xcd + 1)) >> 3);
    idx = start + local + lpx * step;
    if (idx >= end) return false;
  } else {
    idx = vb + step * G;
    if (idx >= T) return false;
  }
  const int strip = idx / (MT * GW), rem = idx % (MT * GW);
  mt = rem / GW; nt = strip * GW + rem % GW;
  return true;
}

#define EPI_COORDS const int t = threadIdx.x, lane = t & 63, w = t >> 6, wm = w >> 1, wn = w & 1, r = lane & 15, q = lane >> 4; (void)wm; (void)wn; (void)r; (void)q;

DI void sample_splitk_task(float* obase, int ldo, const bf16_t* A, int lda, const bf16_t* Bt, int ldb, int nt, int ks, char* smem) {
  f32x4 acc[4][4];
  gemm_std(A + (size_t)ks * 256, lda, NTOK, Bt + (size_t)ks * 256, ldb, nt * 128, 4, acc, smem);
  EPI_COORDS
#pragma unroll
  for (int mi = 0; mi < 4; ++mi)
#pragma unroll
    for (int ni = 0; ni < 4; ++ni) {
      float* o = obase + (size_t)(wm * 64 + mi * 16 + r) * ldo + nt * 128 + wn * 64 + ni * 16 + q * 4;
#pragma unroll
      for (int j = 0; j < 4; ++j) unsafeAtomicAdd(o + j, acc[mi][ni][j]);
    }
}

#ifndef REP_MODE
#define REP_MODE 0
#endif
template <int PMODE>
DI void phase1(const Params& p, char* smem, int vb) {
  constexpr int NT = 20, MT = 128;
  if (PMODE == 0 && vb < 80) sample_splitk_task(p.sproj, NPROJ, p.XN, 1024, p.WinT, 1024, vb % 20, vb / 20, smem);
  for (int step = 0;; ++step) {
    int mt, nt;
    if (!get_tile_strip(vb, step, MT, NT, 4, mt, nt)) break;
    f32x4 acc[4][4];
    if (PMODE == 2) gemm_std<0>(p.XN, 1024, 0, p.WinT, 1024, 0, 16, acc, smem);
    else gemm_std<PMODE>(p.XN, 1024, mt * 128, p.WinT, 1024, nt * 128, 16, acc, smem);
    if (PMODE != 0 && p.ctr[40] == 0) continue;
    EPI_COORDS
#pragma unroll
    for (int mi = 0; mi < 4; ++mi)
#pragma unroll
      for (int ni = 0; ni < 4; ++ni) {
        const int row = mt * 128 + wm * 64 + mi * 16 + r, col = nt * 128 + wn * 64 + ni * 16 + q * 4;
        uint2 pk; pk.x = pack2(acc[mi][ni][0], acc[mi][ni][1]); pk.y = pack2(acc[mi][ni][2], acc[mi][ni][3]);
        *(uint2*)(p.PROJ + (size_t)row * NPROJ + col) = pk;
      }
  }
}

DI void s5_disc(const Params& p, int g, int n, float& abr, float& abi, float& fre, float& fim) {
  const float ar = p.a_re[g * 64 + n], ai = p.a_im[g * 64 + n], dt = expf(p.log_dt[g]);
  const float mag = expf(ar * dt);
  float sn, cs; sincosf(ai * dt, &sn, &cs);
  abr = mag * cs; abi = mag * sn;
  const float den = ar * ar + ai * ai, pp = abr - 1.f;
  fre = (pp * ar + abi * ai) / den; fim = (abi * ar - pp * ai) / den;
}

__device__ void s5_scan_item(const Params& p, int item, char* smem) {
  const int b = item >> 5, g = item & 31;
  float* Xs = (float*)smem;
  bf16_t* Hs = (bf16_t*)(smem + 32768);
  bf16_t* Us = (bf16_t*)(smem + 32768 + 17408);
  const int t = threadIdx.x, lane = t & 63, w = t >> 6, r = lane & 15, q = lane >> 4;
  for (int i = t; i < 64 * 40; i += 256) Us[i] = 0;
  bf16x8 bfrag[2];
#pragma unroll
  for (int x = 0; x < 2; ++x) {
    const int np = (2 * w + x) * 16 + r, n = np >> 1, part = np & 1;
    float abr, abi, fre, fim; s5_disc(p, g, n, abr, abi, fre, fim);
#pragma unroll
    for (int jj = 0; jj < 8; ++jj) {
      float val = 0.f;
      if (q < 2) {
        const int c = q * 8 + jj;
        const float br = p.b_re[(size_t)(g * 64 + n) * 16 + c], bi = p.b_im[(size_t)(g * 64 + n) * 16 + c];
        val = part == 0 ? fre * br - fim * bi : fre * bi + fim * br;
      }
      bfrag[x][jj] = (short)f2bf(val);
    }
  }
  bf16x8 cfrag[4];
#pragma unroll
  for (int ks = 0; ks < 4; ++ks)
#pragma unroll
    for (int jj = 0; jj < 8; ++jj) {
      const int k = ks * 32 + q * 8 + jj;
      const float val = (k & 1) == 0 ? p.c_re[(size_t)(g * 16 + r) * 64 + (k >> 1)] : -p.c_im[(size_t)(g * 16 + r) * 64 + (k >> 1)];
      cfrag[ks][jj] = (short)f2bf(val);
    }
  float abr, abi, hr = 0.f, hi = 0.f;
  { float fre, fim; s5_disc(p, g, lane, abr, abi, fre, fim); }
  const float dcoef = p.s5_d[g * 16 + r];
  __syncthreads();
  u32x4 unext = u32x4{0u, 0u, 0u, 0u};
  if (t < 128) unext = *(const u32x4*)(p.PROJ + ((size_t)b * 2048 + (t >> 1)) * NPROJ + g * 16 + (t & 1) * 8);
  for (int ch = 0; ch < 32; ++ch) {
    const size_t tok0 = (size_t)b * 2048 + ch * 64;
    if (t < 128) {
      *(u32x4*)(Us + (t >> 1) * 40 + (t & 1) * 8) = unext;
      if (ch + 1 < 32) unext = *(const u32x4*)(p.PROJ + (tok0 + 64 + (t >> 1)) * NPROJ + g * 16 + (t & 1) * 8);
    }
    lds_barrier();
    {
      bf16x8 af[4];
#pragma unroll
      for (int mt = 0; mt < 4; ++mt) af[mt] = *(const bf16x8*)(Us + (mt * 16 + r) * 40 + q * 8);
#pragma unroll
      for (int x = 0; x < 2; ++x)
#pragma unroll
        for (int mt = 0; mt < 4; ++mt) {
          f32x4 z = f32x4{0.f, 0.f, 0.f, 0.f};
          z = mfma16(af[mt], bfrag[x], z);
          const int col = (2 * w + x) * 16 + r;
#pragma unroll
          for (int j = 0; j < 4; ++j) Xs[(mt * 16 + q * 4 + j) * 128 + col] = z[j];
        }
    }
    lds_barrier();
    if (w == 0) {
      for (int tb = 0; tb < 8; ++tb) {
        f32x2_t xv[8];
#pragma unroll
        for (int u = 0; u < 8; ++u) xv[u] = *(const f32x2_t*)(Xs + (tb * 8 + u) * 128 + 2 * lane);
#pragma unroll
        for (int u = 0; u < 8; ++u) {
          const float nr = abr * hr - abi * hi + xv[u][0], ni = abr * hi + abi * hr + xv[u][1];
          hr = nr; hi = ni;
          *(unsigned*)(Hs + (tb * 8 + u) * 136 + 2 * lane) = pack2(hr, hi);
        }
      }
    }
    lds_barrier();
    {
      f32x4 y = f32x4{0.f, 0.f, 0.f, 0.f};
#pragma unroll
      for (int ks = 0; ks < 4; ++ks) { const bf16x8 a = *(const bf16x8*)(Hs + (w * 16 + r) * 136 + ks * 32 + q * 8); y = mfma16(a, cfrag[ks], y); }
#pragma unroll
      for (int j = 0; j < 4; ++j) {
        const int tk = w * 16 + q * 4 + j;
        const float u = bf2f(Us[tk * 40 + r]);
        p.ys5[(tok0 + tk) * 512 + g * 16 + r] = f2bf(geluf_(y[j] + dcoef * u));
      }
    }
    lds_barrier();
  }
  if (w == 0) { p.p_s5_re[(size_t)(b * 32 + g) * 64 + lane] = hr; p.p_s5_im[(size_t)(b * 32 + g) * 64 + lane] = hi; }
}

__device__ void s5_decode_item(const Params& p, int s, char* smem) {
  float* us = (float*)smem; float* hre = us + 512; float* him = hre + 2048;
  const int t = threadIdx.x; const size_t row = NTOK + s;
  __syncthreads();
  for (int i = t; i < 512; i += 256) us[i] = p.sproj[(size_t)s * NPROJ + i];
  __syncthreads();
  for (int gq = 0; gq < 8; ++gq) {
    const int g = gq * 4 + (t >> 6), n = t & 63;
    float abr, abi, fre, fim; s5_disc(p, g, n, abr, abi, fre, fim);
    const float* br = p.b_re + (size_t)(g * 64 + n) * 16; const float* bi = p.b_im + (size_t)(g * 64 + n) * 16;
    float bur = 0.f, bui = 0.f;
#pragma unroll
    for (int c = 0; c < 16; ++c) { const float u = us[g * 16 + c]; bur += br[c] * u; bui += bi[c] * u; }
    const float xr = fre * bur - fim * bui, xi = fre * bui + fim * bur;
    const size_t si = (size_t)(s * 32 + g) * 64 + n;
    const float h0r = p.st_s5_re[si], h0i = p.st_s5_im[si];
    const float hr = abr * h0r - abi * h0i + xr, hi = abr * h0i + abi * h0r + xi;
    p.s_s5_re[si] = hr; p.s_s5_im[si] = hi;
    hre[g * 64 + n] = hr; him[g * 64 + n] = hi;
  }
  __syncthreads();
  for (int o = t; o < 512; o += 256) {
    const int g = o >> 4;
    const float* cr = p.c_re + (size_t)o * 64; const float* ci = p.c_im + (size_t)o * 64;
    float y = 0.f;
    for (int n = 0; n < 64; ++n) y += cr[n] * hre[g * 64 + n] - ci[n] * him[g * 64 + n];
    y += p.s5_d[o] * us[o];
    p.ys5[row * 512 + o] = f2bf(geluf_(y));
  }
  __syncthreads();
}

__device__ void gdn_prep_item(const Params& p, int item, char* smem) {
  const int c = item & 31, h = (item >> 5) & 3, b = item >> 7;
  bf16_t* Kn = (bf16_t*)smem;
  bf16_t* Qn = (bf16_t*)(smem + 16384);
  float* Lm = (float*)(smem + 16384);
  bf16_t* Vs = (bf16_t*)(smem + 32768);
  float* gcs = (float*)(smem + 49152);
  float* bts = gcs + 64;
  float* egs = bts + 64;
  const int t = threadIdx.x, lane = t & 63, w = t >> 6, r = lane & 15, q = lane >> 4;
  const int tok0 = c * 64; const size_t row0 = (size_t)b * 2048 + tok0;
  bf16_t* gi = p.GDNI + (size_t)item * 36864;
  __syncthreads();
  if (w == 0) {
    const float* bar = p.ba + (row0 + lane) * 8;
    const float beta = sigmoidf_(bar[h]);
    const float xx = bar[4 + h] + p.dt_bias[h];
    const float sp = fmaxf(xx, 0.f) + log1pf(expf(-fabsf(xx)));
    float s = -expf(p.a_log[h]) * sp;
    for (int o = 1; o < 64; o <<= 1) { const float y = __shfl_up(s, o); if (lane >= o) s += y; }
    gcs[lane] = s; bts[lane] = beta; egs[lane] = expf(s);
  }
  __syncthreads();
  if (c == 31) {
    for (int idx = t; idx < 1152; idx += 256) {
      const int i = idx / 384, rem = idx % 384, X = rem >> 7, cc = rem & 127;
      const int col = X * 512 + h * 128 + cc;
      p.p_gdn_conv[(size_t)(b * 3 + i) * 1536 + col] = bf2f(p.PROJ[((size_t)b * 2048 + 2045 + i) * NPROJ + 512 + col]);
    }
  }
  {
    const int row = t >> 2, seg = t & 3;
    const float eg = egs[row], ekg = expf(gcs[63] - gcs[row]);
    const int tok = tok0 + row;
#pragma unroll
    for (int X = 0; X < 3; ++X) {
      float val[32]; float ss = 0.f;
      const int colbase = X * 512 + h * 128 + seg * 32;
#pragma unroll
      for (int cb = 0; cb < 4; ++cb) {
        float a8[8];
#pragma unroll
        for (int e = 0; e < 8; ++e) a8[e] = 0.f;
#pragma unroll
        for (int tap = 0; tap < 4; ++tap) {
          const int tk = tok - 3 + tap;
          if (tk >= 0) {
            const uint4 raw = *(const uint4*)(p.PROJ + ((size_t)b * 2048 + tk) * NPROJ + 512 + colbase + cb * 8);
            const float* wp = p.gdn_conv_w + tap * 1536 + colbase + cb * 8;
            const float4 w0 = *(const float4*)wp, w1 = *(const float4*)(wp + 4);
            a8[0] += bflo(raw.x) * w0.x; a8[1] += bfhi(raw.x) * w0.y; a8[2] += bflo(raw.y) * w0.z; a8[3] += bfhi(raw.y) * w0.w;
            a8[4] += bflo(raw.z) * w1.x; a8[5] += bfhi(raw.z) * w1.y; a8[6] += bflo(raw.w) * w1.z; a8[7] += bfhi(raw.w) * w1.w;
          }
        }
#pragma unroll
        for (int e = 0; e < 8; ++e) { const float v = siluf_(a8[e]); val[cb * 8 + e] = v; ss += v * v; }
        __builtin_amdgcn_sched_barrier(0);
      }
      if (X < 2) {
        ss += __shfl_xor(ss, 1); ss += __shfl_xor(ss, 2);
        const float sc = rsqrtf(ss + 1e-6f) * (X == 0 ? 0.08838834764831845f : 1.f);
#pragma unroll
        for (int e = 0; e < 32; ++e) val[e] *= sc;
      }
      if (X == 0) {
#pragma unroll
        for (int cb = 0; cb < 4; ++cb) {
          uint4 pk; pk.x = pack2(val[cb * 8], val[cb * 8 + 1]); pk.y = pack2(val[cb * 8 + 2], val[cb * 8 + 3]); pk.z = pack2(val[cb * 8 + 4], val[cb * 8 + 5]); pk.w = pack2(val[cb * 8 + 6], val[cb * 8 + 7]);
          *(uint4*)(Qn + row * 128 + (((seg * 4 + cb) ^ (row & 15)) * 8)) = pk;
          uint4 pg; pg.x = pack2(val[cb * 8] * eg, val[cb * 8 + 1] * eg); pg.y = pack2(val[cb * 8 + 2] * eg, val[cb * 8 + 3] * eg); pg.z = pack2(val[cb * 8 + 4] * eg, val[cb * 8 + 5] * eg); pg.w = pack2(val[cb * 8 + 6] * eg, val[cb * 8 + 7] * eg);
          *(uint4*)(gi + 16384 + row * 128 + seg * 32 + cb * 8) = pg;
        }
      } else if (X == 1) {
#pragma unroll
        for (int cb = 0; cb < 4; ++cb) {
          uint4 pk; pk.x = pack2(val[cb * 8], val[cb * 8 + 1]); pk.y = pack2(val[cb * 8 + 2], val[cb * 8 + 3]); pk.z = pack2(val[cb * 8 + 4], val[cb * 8 + 5]); pk.w = pack2(val[cb * 8 + 6], val[cb * 8 + 7]);
          *(uint4*)(Kn + row * 128 + (((seg * 4 + cb) ^ (row & 15)) * 8)) = pk;
        }
#pragma unroll
        for (int e = 0; e < 32; ++e) gi[24576 + (seg * 32 + e) * 64 + row] = f2bf(val[e] * ekg);
      } else {
#pragma unroll
        for (int cb = 0; cb < 4; ++cb) {
          uint4 pk; pk.x = pack2(val[cb * 8], val[cb * 8 + 1]); pk.y = pack2(val[cb * 8 + 2], val[cb * 8 + 3]); pk.z = pack2(val[cb * 8 + 4], val[cb * 8 + 5]); pk.w = pack2(val[cb * 8 + 6], val[cb * 8 + 7]);
          *(uint4*)(Vs + row * 128 + seg * 32 + cb * 8) = pk;
        }
      }
    }
  }
  __syncthreads();
  f32x4 kk[4], qk[4];
  {
    bf16x8 ak[4], aq[4];
    const int rowA = w * 16 + r;
#pragma unroll
    for (int ks = 0; ks < 4; ++ks) { const int phys = (ks * 4 + q) ^ r; ak[ks] = *(const bf16x8*)(Kn + rowA * 128 + phys * 8); aq[ks] = *(const bf16x8*)(Qn + rowA * 128 + phys * 8); }
#pragma unroll
    for (int nt = 0; nt < 4; ++nt) {
      kk[nt] = f32x4{0.f, 0.f, 0.f, 0.f}; qk[nt] = f32x4{0.f, 0.f, 0.f, 0.f};
      if (nt <= w) {
        const int rowB = nt * 16 + r;
#pragma unroll
        for (int ks = 0; ks < 4; ++ks) {
          const int phys = (ks * 4 + q) ^ r;
          const bf16x8 bb = *(const bf16x8*)(Kn + rowB * 128 + phys * 8);
          kk[nt] = mfma16(ak[ks], bb, kk[nt]); qk[nt] = mfma16(aq[ks], bb, qk[nt]);
        }
      }
    }
  }
  __syncthreads();
#pragma unroll
  for (int nt = 0; nt < 4; ++nt)
#pragma unroll
    for (int j = 0; j < 4; ++j) {
      const int i = w * 16 + q * 4 + j, jc = nt * 16 + r;
      const float dec = __expf(fminf(gcs[i] - gcs[jc], 0.f));
      Lm[i * 64 + jc] = (i > jc) ? bts[i] * kk[nt][j] * dec : 0.f;
      gi[32768 + i * 64 + jc] = f2bf((i >= jc) ? qk[nt][j] * dec : 0.f);
    }
  __syncthreads();
  {
    float sol[64];
    const bool isv = t < 128;
    const int kc = t - 128;
    if (isv) {
#pragma unroll
      for (int i = 0; i < 64; ++i) { sol[i] = bf2f(Vs[i * 128 + t]) * bts[i]; if ((i & 7) == 7) __builtin_amdgcn_sched_barrier(0); }
    } else {
#pragma unroll
      for (int i = 0; i < 64; ++i) { sol[i] = bf2f(Kn[i * 128 + (((kc >> 3) ^ (i & 15)) * 8) + (kc & 7)]) * bts[i] * egs[i]; if ((i & 7) == 7) __builtin_amdgcn_sched_barrier(0); }
    }
    __builtin_amdgcn_sched_barrier(0);
#pragma unroll
    for (int i = 1; i < 64; ++i) {
      float a = sol[i];
#pragma unroll
      for (int jb = 0; jb < (i + 3) / 4; ++jb) {
        const float4 l = *(const float4*)(Lm + i * 64 + jb * 4);
        if (jb * 4 + 0 < i) a -= l.x * sol[jb * 4 + 0];
        if (jb * 4 + 1 < i) a -= l.y * sol[jb * 4 + 1];
        if (jb * 4 + 2 < i) a -= l.z * sol[jb * 4 + 2];
        if (jb * 4 + 3 < i) a -= l.w * sol[jb * 4 + 3];
      }
      sol[i] = a;
      __builtin_amdgcn_sched_barrier(0);
    }
    bf16_t* go = gi + t + (isv ? 0 : 8192 - 128);
#pragma unroll
    for (int i = 0; i < 64; ++i) { go[i * 128] = f2bf(sol[i]); if ((i & 7) == 7) __builtin_amdgcn_sched_barrier(0); }
  }
  if (t == 0) p.glast[item] = egs[63];
}

__device__ void gdn_decode_item(const Params& p, int item, char* smem) {
  const int h = item & 3, s = item >> 2; const size_t row = NTOK + s;
  float* qs = (float*)smem; float* ks = qs + 128; float* vs = ks + 128; float* part = vs + 128; float* red = part + 512;
  const int t = threadIdx.x;
  __syncthreads();
  float cv[3] = {0.f, 0.f, 0.f};
  if (t < 128) {
#pragma unroll
    for (int X = 0; X < 3; ++X) {
      const int col = X * 512 + h * 128 + t;
      const float* buf = p.st_gdn_conv + (size_t)s * 3 * 1536 + col;
      const float b0 = buf[0], b1 = buf[1536], b2 = buf[3072];
      const float nw = p.sproj[(size_t)s * NPROJ + 512 + col];
      const float* cw = p.gdn_conv_w + col;
      const float a = b0 * cw[0] + b1 * cw[1536] + b2 * cw[3072] + nw * cw[4608];
      cv[X] = siluf_(a);
      float* ob = p.s_gdn_conv + (size_t)s * 3 * 1536 + col;
      ob[0] = b1; ob[1536] = b2; ob[3072] = nw;
    }
  }
  const float sq = block_sum(cv[0] * cv[0], red), sk = block_sum(cv[1] * cv[1], red);
  const float qn = cv[0] * rsqrtf(sq + 1e-6f) * 0.08838834764831845f, kn = cv[1] * rsqrtf(sk + 1e-6f);
  const float qk = block_sum(qn * kn, red);
  if (t < 128) { qs[t] = qn; ks[t] = kn; vs[t] = cv[2]; }
  const float beta = sigmoidf_(p.ba[row * 8 + h]);
  const float xx = p.ba[row * 8 + 4 + h] + p.dt_bias[h];
  const float eg = expf(-expf(p.a_log[h]) * (fmaxf(xx, 0.f) + log1pf(expf(-fabsf(xx)))));
  __syncthreads();
  const int e = t & 127, dh = t >> 7;
  const size_t soff = ((size_t)(s * 4 + h) * 128 + dh * 64) * 128 + e;
  const float* S0 = p.st_gdn + soff;
  float sr[64]; float kS = 0.f, qS = 0.f;
#pragma unroll
  for (int d = 0; d < 64; ++d) { sr[d] = S0[(size_t)d * 128]; kS += ks[dh * 64 + d] * sr[d]; qS += qs[dh * 64 + d] * sr[d]; }
  part[dh * 128 + e] = kS; part[256 + dh * 128 + e] = qS;
  __syncthreads();
  kS = part[e] + part[128 + e]; qS = part[256 + e] + part[384 + e];
  const float vn = beta * (vs[e] - eg * kS);
  const float o = eg * qS + qk * vn;
  float* S1 = p.s_gdn + soff;
#pragma unroll
  for (int d = 0; d < 64; ++d) S1[(size_t)d * 128] = sr[d] * eg + ks[dh * 64 + d] * vn;
  const float so = block_sum(dh == 0 ? o * o : 0.f, red);
  if (dh == 0) {
    const float z = p.sproj[(size_t)s * NPROJ + 2048 + h * 128 + e];
    p.XN[row * 1024 + 512 + h * 128 + e] = f2bf(o * rsqrtf(so * (1.f / 128.f) + 1e-6f) * p.onorm_g[e] * siluf_(z));
  }
  __syncthreads();
}

#ifndef REP_MASK
#define REP_MASK 15
#endif
template <int MASK>
DI void phase2(const Params& p, char* smem, int cofs) {
  constexpr int N_S5 = 256, N_PREP = 1024, N_SDEC = 128;
  for (;;) {
    int it = fetch_item(p.ctr + 2 + cofs);
    if (it >= N_S5 + N_PREP + N_SDEC) break;
    if (it < N_S5) { if (MASK & 1) s5_scan_item(p, it, smem); continue; }
    it -= N_S5;
    if (it < N_PREP) { if (MASK & 2) gdn_prep_item(p, it, smem); continue; }
    it -= N_PREP;
    if (MASK & 8) s5_decode_item(p, it, smem);
  }
}

__device__ void gdn_seq_item(const Params& p, int item, char* smem) {
  const int sl = item & 3, h = (item >> 2) & 3, b = item >> 4;
  bf16_t* ST = (bf16_t*)smem;
  bf16_t* VT = (bf16_t*)(smem + 8704);
  const int t = threadIdx.x, lane = t & 63, w = t >> 6, r = lane & 15, q = lane >> 4;
  __syncthreads();
  for (int i = t; i < 32 * 136; i += 256) ST[i] = 0;
  f32x4 sacc[2][2];
#pragma unroll
  for (int mi = 0; mi < 2; ++mi)
#pragma unroll
    for (int ni = 0; ni < 2; ++ni) sacc[mi][ni] = f32x4{0.f, 0.f, 0.f, 0.f};
  bf16x8 W0[4], Q0[4], A0[2], K0[2][2], A1[2], K1[2][2];
  unsigned U0[2][4]; float g0;
  const bf16_t* gbase = p.GDNI + (size_t)((b * 4 + h) * 32) * 36864;
  const float* glb = p.glast + (b * 4 + h) * 32;
#define SEQ_LOAD_WQU(S, C) { \
    const bf16_t* gi_ = gbase + (size_t)(C) * 36864; \
    _Pragma("unroll") for (int ks = 0; ks < 4; ++ks) { \
      W##S[ks] = *(const bf16x8*)(gi_ + 8192 + (w * 16 + r) * 128 + ks * 32 + q * 8); \
      Q##S[ks] = *(const bf16x8*)(gi_ + 16384 + (w * 16 + r) * 128 + ks * 32 + q * 8); } \
    _Pragma("unroll") for (int ni = 0; ni < 2; ++ni) _Pragma("unroll") for (int j = 0; j < 4; ++j) \
      U##S[ni][j] = (unsigned)gi_[(w * 16 + q * 4 + j) * 128 + sl * 32 + ni * 16 + r]; \
    g##S = glb[(C)]; }
#define SEQ_LOAD_AK(S, C) { \
    const bf16_t* gi_ = gbase + (size_t)(C) * 36864; \
    _Pragma("unroll") for (int k2 = 0; k2 < 2; ++k2) { \
      A##S[k2] = *(const bf16x8*)(gi_ + 32768 + (w * 16 + r) * 64 + k2 * 32 + q * 8); \
      _Pragma("unroll") for (int mi = 0; mi < 2; ++mi) K##S[mi][k2] = *(const bf16x8*)(gi_ + 24576 + ((2 * w + mi) * 16 + r) * 64 + k2 * 32 + q * 8); } }
#define SEQ_CHUNK(S, T, C) { \
    f32x4 vacc[2], oacc[2]; \
    _Pragma("unroll") for (int ni = 0; ni < 2; ++ni) { vacc[ni] = f32x4{0.f, 0.f, 0.f, 0.f}; oacc[ni] = f32x4{0.f, 0.f, 0.f, 0.f}; } \
    _Pragma("unroll") for (int ks = 0; ks < 4; ++ks) { \
      _Pragma("unroll") for (int ni = 0; ni < 2; ++ni) { \
        const bf16x8 bs = *(const bf16x8*)(ST + (ni * 16 + r) * 136 + ks * 32 + q * 8); \
        vacc[ni] = mfma16(W0[ks], bs, vacc[ni]); oacc[ni] = mfma16(bs, Q0[ks], oacc[ni]); } } \
    _Pragma("unroll") for (int ni = 0; ni < 2; ++ni) { \
      float vn[4]; \
      _Pragma("unroll") for (int j = 0; j < 4; ++j) vn[j] = __uint_as_float(U0[ni][j] << 16) - vacc[ni][j]; \
      uint2 pk; pk.x = pack2(vn[0], vn[1]); pk.y = pack2(vn[2], vn[3]); \
      *(uint2*)(VT + (ni * 16 + r) * 72 + w * 16 + q * 4) = pk; } \
    const float gl = g0; \
    __builtin_amdgcn_sched_barrier(0); \
    if ((C) + 1 < 32) { SEQ_LOAD_WQU(0, (C) + 1) SEQ_LOAD_AK(T, (C) + 1) } \
    __builtin_amdgcn_sched_barrier(0); \
    lds_barrier(); \
    bf16x8 bv[2][2]; \
    _Pragma("unroll") for (int ni = 0; ni < 2; ++ni) _Pragma("unroll") for (int k2 = 0; k2 < 2; ++k2) bv[ni][k2] = *(const bf16x8*)(VT + (ni * 16 + r) * 72 + k2 * 32 + q * 8); \
    _Pragma("unroll") for (int k2 = 0; k2 < 2; ++k2) _Pragma("unroll") for (int ni = 0; ni < 2; ++ni) oacc[ni] = mfma16(bv[ni][k2], A##S[k2], oacc[ni]); \
    _Pragma("unroll") for (int mi = 0; mi < 2; ++mi) { \
      _Pragma("unroll") for (int ni = 0; ni < 2; ++ni) sacc[mi][ni] *= gl; \
      _Pragma("unroll") for (int k2 = 0; k2 < 2; ++k2) _Pragma("unroll") for (int ni = 0; ni < 2; ++ni) sacc[mi][ni] = mfma16(K##S[mi][k2], bv[ni][k2], sacc[mi][ni]); } \
    __builtin_amdgcn_sched_barrier(0); \
    __builtin_amdgcn_sched_barrier(0); \
    _Pragma("unroll") for (int ni = 0; ni < 2; ++ni) { \
      float4 o; o.x = oacc[ni][0]; o.y = oacc[ni][1]; o.z = oacc[ni][2]; o.w = oacc[ni][3]; \
      *(float4*)(p.ogdn + ((size_t)b * 2048 + (C) * 64 + w * 16 + r) * 512 + h * 128 + sl * 32 + ni * 16 + q * 4) = o; } \
    _Pragma("unroll") for (int mi = 0; mi < 2; ++mi) _Pragma("unroll") for (int ni = 0; ni < 2; ++ni) { \
      uint2 pk; pk.x = pack2(sacc[mi][ni][0], sacc[mi][ni][1]); pk.y = pack2(sacc[mi][ni][2], sacc[mi][ni][3]); \
      *(uint2*)(ST + (ni * 16 + r) * 136 + (2 * w + mi) * 16 + q * 4) = pk; } \
    lds_barrier(); }
  SEQ_LOAD_WQU(0, 0)
  SEQ_LOAD_AK(0, 0)
  __syncthreads();
  for (int c = 0; c < 32; c += 2) {
    SEQ_CHUNK(0, 1, c)
    SEQ_CHUNK(1, 0, c + 1)
  }
#undef SEQ_LOAD_WQU
#undef SEQ_LOAD_AK
#undef SEQ_CHUNK
#pragma unroll
  for (int mi = 0; mi < 2; ++mi)
#pragma unroll
    for (int ni = 0; ni < 2; ++ni)
#pragma unroll
      for (int j = 0; j < 4; ++j)
        p.p_gdn[((size_t)(b * 4 + h) * 128 + (2 * w + mi) * 16 + q * 4 + j) * 128 + sl * 32 + ni * 16 + r] = sacc[mi][ni][j];
}

__device__ void glu_tile(const Params& p, int idx, char* smem) {
  const int mt = idx >> 3, nt = idx & 7;
  f32x4 acc[4][4];
  gemm_std(p.ys5, 512, mt * 128, p.WgluT, 512, nt * 128, 8, acc, smem);
  EPI_COORDS
#pragma unroll
  for (int mi = 0; mi < 4; ++mi)
#pragma unroll
    for (int ni = 0; ni < 2; ++ni) {
      const int row = mt * 128 + wm * 64 + mi * 16 + r, col = nt * 64 + wn * 32 + ni * 16 + q * 4;
      float o[4];
#pragma unroll
      for (int j = 0; j < 4; ++j) o[j] = acc[mi][ni][j] * sigmoidf_(acc[mi][ni + 2][j]);
      uint2 pk; pk.x = pack2(o[0], o[1]); pk.y = pack2(o[2], o[3]);
      *(uint2*)(p.XN + (size_t)row * 1024 + col) = pk;
    }
}

template <int MASK>
DI void phase3(const Params& p, char* smem, int cofs) {
  constexpr int N_SEQ = 128, N_GLU = 129 * 8, N_GDEC = 512;
  for (;;) {
    int it = fetch_item(p.ctr + 3 + cofs);
    if (it >= N_SEQ + N_GLU + N_GDEC) break;
    if (it < N_SEQ) { if (MASK & 1) gdn_seq_item(p, it, smem); }
    else if (it < N_SEQ + N_GLU) { if (MASK & 2) glu_tile(p, it - N_SEQ, smem); }
    else { if (MASK & 2) gdn_decode_item(p, it - N_SEQ - N_GLU, smem); }
  }
}

__device__ void phase4(const Params& p) {
  const int lane = threadIdx.x & 63, w = threadIdx.x >> 6;
  for (int i = blockIdx.x * 256 + threadIdx.x; i < 128 * 1024 / 4; i += gridDim.x * 256)
    *(float4*)(p.out + (size_t)NTOK * 1024 + (size_t)i * 4) = *(const float4*)(p.x_sample + (size_t)i * 4);
  for (int it = blockIdx.x; it < NTOK / 4; it += gridDim.x) {
    const size_t row = (size_t)it * 4 + w;
    const float* op = p.ogdn + row * 512 + lane * 8;
    const float4 o0 = *(const float4*)op, o1 = *(const float4*)(op + 4);
    float ss = o0.x * o0.x + o0.y * o0.y + o0.z * o0.z + o0.w * o0.w + o1.x * o1.x + o1.y * o1.y + o1.z * o1.z + o1.w * o1.w;
    ss += __shfl_xor(ss, 1); ss += __shfl_xor(ss, 2); ss += __shfl_xor(ss, 4); ss += __shfl_xor(ss, 8);
    const float rs = rsqrtf(ss * (1.f / 128.f) + 1e-6f);
    const uint4 zr = *(const uint4*)(p.PROJ + row * NPROJ + 2048 + lane * 8);
    const float* gp = p.onorm_g + (lane & 15) * 8;
    const float4 g0 = *(const float4*)gp, g1 = *(const float4*)(gp + 4);
    uint4 pk;
    pk.x = pack2(o0.x * rs * g0.x * siluf_(bflo(zr.x)), o0.y * rs * g0.y * siluf_(bfhi(zr.x)));
    pk.y = pack2(o0.z * rs * g0.z * siluf_(bflo(zr.y)), o0.w * rs * g0.w * siluf_(bfhi(zr.y)));
    pk.z = pack2(o1.x * rs * g1.x * siluf_(bflo(zr.z)), o1.y * rs * g1.y * siluf_(bfhi(zr.z)));
    pk.w = pack2(o1.z * rs * g1.z * siluf_(bflo(zr.w)), o1.w * rs * g1.w * siluf_(bfhi(zr.w)));
    *(uint4*)(p.XN + row * 1024 + 512 + lane * 8) = pk;
  }
}

__device__ void phase5(const Params& p, char* smem, int vb) {
  for (int step = 0;; ++step) {
    int mt, nt; bool valid;
    if (!get_tile(vb, step, 128, 8, 8, mt, nt, valid)) break;
    if (!valid) continue;
    f32x4 acc[4][4];
    gemm_std(p.XN, 1024, mt * 128, p.WoutT, 1024, nt * 128, 16, acc, smem);
    EPI_COORDS
#pragma unroll
    for (int mi = 0; mi < 4; ++mi) {
      const int row = mt * 128 + wm * 64 + mi * 16 + r;
      const float* xr = xin_row(p, row);
      float4 xv[4];
#pragma unroll
      for (int ni = 0; ni < 4; ++ni) xv[ni] = *(const float4*)(xr + nt * 128 + wn * 64 + ni * 16 + q * 4);
#pragma unroll
      for (int ni = 0; ni < 4; ++ni) {
        float4 o; o.x = xv[ni].x + acc[mi][ni][0]; o.y = xv[ni].y + acc[mi][ni][1]; o.z = xv[ni].z + acc[mi][ni][2]; o.w = xv[ni].w + acc[mi][ni][3];
        *(float4*)(p.out + (size_t)row * 1024 + nt * 128 + wn * 64 + ni * 16 + q * 4) = o;
      }
    }
  }
  if (vb < 32) sample_splitk_task(p.out + (size_t)NTOK * 1024, 1024, p.XN, 1024, p.WoutT, 1024, vb & 7, vb >> 3, smem);
}

__device__ void phase_norm(const Params& p, bool final_) {
  const int lane = threadIdx.x & 63, w = threadIdx.x >> 6;
  const float* gw = final_ ? p.normf_g : p.norm2_g;
  float4 g[4];
#pragma unroll
  for (int i = 0; i < 4; ++i) g[i] = *(const float4*)(gw + i * 256 + lane * 4);
  for (int it = blockIdx.x; it < MROWS / 8; it += gridDim.x) {
    float4 v[2][4];
#pragma unroll
    for (int rr = 0; rr < 2; ++rr)
#pragma unroll
      for (int i = 0; i < 4; ++i) v[rr][i] = *(const float4*)(p.out + ((size_t)it * 8 + rr * 4 + w) * 1024 + i * 256 + lane * 4);
#pragma unroll
    for (int rr = 0; rr < 2; ++rr) {
      const size_t row = (size_t)it * 8 + rr * 4 + w;
      float* xr = p.out + row * 1024;
      float ss = 0.f;
#pragma unroll
      for (int i = 0; i < 4; ++i) ss += v[rr][i].x * v[rr][i].x + v[rr][i].y * v[rr][i].y + v[rr][i].z * v[rr][i].z + v[rr][i].w * v[rr][i].w;
      ss = wave_sum(ss);
      const float rstd = rsqrtf(ss * (1.f / 1024.f) + 1e-6f);
#pragma unroll
      for (int i = 0; i < 4; ++i) {
        float4 o; o.x = v[rr][i].x * rstd * g[i].x; o.y = v[rr][i].y * rstd * g[i].y; o.z = v[rr][i].z * rstd * g[i].z; o.w = v[rr][i].w * rstd * g[i].w;
        if (final_) *(float4*)(xr + i * 256 + lane * 4) = o;
        else { uint2 pk; pk.x = pack2(o.x, o.y); pk.y = pack2(o.z, o.w); *(uint2*)(p.XN + row * 1024 + i * 256 + lane * 4) = pk; }
      }
    }
  }
}

__device__ void phase7(const Params& p, char* smem, int vb) {
  constexpr int NT = 44, MT = 137;
  float* hl = (float*)smem;
  for (int step = 0;; ++step) {
    int mt, nt;
    if (!get_tile_strip(vb, step, MT, NT, 4, mt, nt)) break;
    const bool samp = mt == 136;
    const int bb = mt / 17, ii = mt % 17;
    f32x4 acc[4][4];
    {
      const int t = threadIdx.x;
      unsigned amask = 0;
      long arow0;
      if (samp) { arow0 = NTOK + (t >> 3); amask = 0xfu; }
      else {
        arow0 = (long)bb * 2048 + 126 * ii - 2 + (t >> 3);
#pragma unroll
        for (int i = 0; i < 4; ++i) { const int tok = 126 * ii - 2 + (t >> 3) + 32 * i; if (tok >= 0 && tok < 2048) amask |= 1u << i; }
      }
      const bf16_t* a0 = p.XN + arow0 * 1024 + (t & 7) * 8;
      const bf16_t* b0 = p.WupT + (size_t)(nt * 128 + (t >> 3)) * 1024 + (t & 7) * 8;
      gemm_main<true>(a0, (size_t)32 * 1024, amask, b0, (size_t)32 * 1024, 16, acc, smem);
    }
    EPI_COORDS
    const int jj = t & 31, rg = t >> 5;
#pragma unroll
    for (int hh = 0; hh < 2; ++hh) {
      __syncthreads();
      if (wn == hh) {
#pragma unroll
        for (int mi = 0; mi < 4; ++mi)
#pragma unroll
          for (int ni = 0; ni < 4; ++ni)
#pragma unroll
            for (int j = 0; j < 4; ++j) hl[(wm * 64 + mi * 16 + r) * 64 + ni * 16 + q * 4 + j] = acc[mi][ni][j];
      }
      __syncthreads();
      const int colg = nt * 64 + hh * 32 + jj;
      const float cg0 = p.ffn_conv_w[colg], cg1 = p.ffn_conv_w[5632 + colg], cg2 = p.ffn_conv_w[2 * 5632 + colg];
      const float cu0 = p.ffn_conv_w[2816 + colg], cu1 = p.ffn_conv_w[5632 + 2816 + colg], cu2 = p.ffn_conv_w[2 * 5632 + 2816 + colg];
      if (samp) {
#pragma unroll 2
        for (int rr = 0; rr < 16; ++rr) {
          const int s = rg * 16 + rr;
          const float* sb = p.st_ffn_conv + (size_t)s * 2 * 5632;
          const float g0 = sb[colg], g1 = sb[5632 + colg], u0 = sb[2816 + colg], u1 = sb[5632 + 2816 + colg];
          const float hg = hl[s * 64 + jj], hu = hl[s * 64 + 32 + jj];
          const float gate = g0 * cg0 + g1 * cg1 + hg * cg2, up = u0 * cu0 + u1 * cu1 + hu * cu2;
          p.ACT[(size_t)(NTOK + s) * 2816 + colg] = f2bf(siluf_(gate) * up);
          float* ob = p.s_ffn_conv + (size_t)s * 2 * 5632;
          ob[colg] = g1; ob[2816 + colg] = u1; ob[5632 + colg] = hg; ob[5632 + 2816 + colg] = hu;
        }
      } else {
#pragma unroll 2
        for (int rr = 0; rr < 16; ++rr) {
          const int rowt = rg * 16 + rr;
          const int tok = 126 * ii - 2 + rowt;
          if (rowt >= 2 && tok < 2048) {
            const float gate = hl[(rowt - 2) * 64 + jj] * cg0 + hl[(rowt - 1) * 64 + jj] * cg1 + hl[rowt * 64 + jj] * cg2;
            const float up = hl[(rowt - 2) * 64 + 32 + jj] * cu0 + hl[(rowt - 1) * 64 + 32 + jj] * cu1 + hl[rowt * 64 + 32 + jj] * cu2;
            p.ACT[((size_t)bb * 2048 + tok) * 2816 + colg] = f2bf(siluf_(gate) * up);
            if (tok >= 2046) {
              float* ob = p.p_ffn_conv + (size_t)(bb * 2 + (tok - 2046)) * 5632;
              ob[colg] = hl[rowt * 64 + jj]; ob[2816 + colg] = hl[rowt * 64 + 32 + jj];
            }
          }
        }
      }
    }
  }
}

__device__ void phase8(const Params& p, char* smem, int vb) {
  for (int step = 0;; ++step) {
    int mt, nt; bool valid;
    if (!get_tile(vb, step, 128, 8, 8, mt, nt, valid)) break;
    if (!valid) continue;
    f32x4 acc[4][4];
    gemm_std(p.ACT, 2816, mt * 128, p.WdnT, 2816, nt * 128, 44, acc, smem);
    EPI_COORDS
#pragma unroll
    for (int mi = 0; mi < 4; ++mi) {
      float* orow = p.out + (size_t)(mt * 128 + wm * 64 + mi * 16 + r) * 1024 + nt * 128 + wn * 64 + q * 4;
      float4 xv[4];
#pragma unroll
      for (int ni = 0; ni < 4; ++ni) xv[ni] = *(const float4*)(orow + ni * 16);
#pragma unroll
      for (int ni = 0; ni < 4; ++ni) {
        float4 o; o.x = xv[ni].x + acc[mi][ni][0]; o.y = xv[ni].y + acc[mi][ni][1]; o.z = xv[ni].z + acc[mi][ni][2]; o.w = xv[ni].w + acc[mi][ni][3];
        *(float4*)(orow + ni * 16) = o;
      }
    }
  }
  if (vb < 88) sample_splitk_task(p.out + (size_t)NTOK * 1024, 1024, p.ACT, 2816, p.WdnT, 2816, vb & 7, vb >> 3, smem);
}

template <int PH>
DI void run_phase(const Params& p, char* smem, int vb, int cofs = 0) {
  if (PH == 0) phase0(p, smem);
  else if (PH == 1) { if (cofs) phase1<REP_MODE + 10 * 0>(p, smem, vb); else phase1<0>(p, smem, vb); }
  else if (PH == 2) { if (cofs) phase2<REP_MASK>(p, smem, cofs); else phase2<15>(p, smem, 0); }
  else if (PH == 3) { if (cofs) phase3<(REP_MASK & 3)>(p, smem, cofs); else phase3<3>(p, smem, 0); }
  else if (PH == 4) phase4(p);
  else if (PH == 5) phase5(p, smem, vb);
  else if (PH == 6) phase_norm(p, false);
  else if (PH == 7) phase7(p, smem, vb);
  else if (PH == 8) phase8(p, smem, vb);
  else phase_norm(p, true);
}

template <int PH>
__global__ void __launch_bounds__(256, 2) phase_kernel(Params p) {
  __shared__ __attribute__((aligned(16))) char smem[SMEM_BYTES];
  run_phase<PH>(p, smem, blockIdx.x);
}


#define XB_TMO      128
#define XB_XCNT(j)  (256  + 64 * (j))
#define XB_XSUB(j)  (1280 + 64 * (j))
#define XB_XGEN(j)  (2304 + 64 * (j))
#define XB_TOP      3328
#define XB_TOPGEN   3392
#define XCD_BAR_WORDS 3456
#define XB_SPIN_CAP (1u << 18)
#define LAS __attribute__((address_space(3)))
DI unsigned xb_ld(unsigned* p) { return __hip_atomic_load(p, __ATOMIC_RELAXED, __HIP_MEMORY_SCOPE_AGENT); }
DI unsigned xb_add(unsigned* p, unsigned v) { return __hip_atomic_fetch_add(p, v, __ATOMIC_RELAXED, __HIP_MEMORY_SCOPE_AGENT); }
DI unsigned xb_xcc_id() { return (unsigned)__builtin_amdgcn_s_getreg((3 << 11) | 20) & 0xFu; }
#define XB_SPIN(cond, bar) do { unsigned _sp = 0; while (cond) { __builtin_amdgcn_s_sleep(1); \
    if ((++_sp & 255u) == 0u) { if (xb_ld(&(bar)[XB_TMO])) break; if (_sp > XB_SPIN_CAP) { atomicAdd(&(bar)[XB_TMO], 1u); break; } } } } while (0)
struct XcdBarrier { unsigned* bar; unsigned x; volatile LAS unsigned* st; };
DI XcdBarrier xcd_barrier_post(unsigned* bar, volatile LAS unsigned* st) {
  XcdBarrier b; b.bar = bar; b.x = xb_xcc_id(); b.st = st;
  if (threadIdx.x == 0) (void)xb_add(&bar[XB_XCNT(b.x)], 1u);
  return b;
}
DI void xcd_barrier_complete(unsigned* bar, unsigned x, unsigned& nloc, unsigned& nx) {
  const unsigned G = gridDim.x * gridDim.y * gridDim.z;
  unsigned sum, cnt, mine, sp = 0u;
  for (;;) {
    sum = 0u; cnt = 0u; mine = 0u;
#pragma unroll
    for (unsigned j = 0; j < 16; ++j) { const unsigned c = xb_ld(&bar[XB_XCNT(j)]); sum += c; cnt += (c > 0u) ? 1u : 0u; mine = (j == x) ? c : mine; }
    if (sum == G) break;
    __builtin_amdgcn_s_sleep(1);
    if ((++sp & 255u) == 0u) { if (xb_ld(&bar[XB_TMO])) break; if (sp > XB_SPIN_CAP) { atomicAdd(&bar[XB_TMO], 1u); break; } }
  }
  nloc = mine > 0u ? mine : 1u; nx = cnt > 0u ? cnt : 1u;
}
DI void xcd_barrier(const XcdBarrier& b) {
  asm volatile("s_waitcnt vmcnt(0)" ::: "memory");
  __syncthreads();
  if (threadIdx.x == 0) {
    unsigned* bar = b.bar;
    __builtin_amdgcn_s_waitcnt(0);
    unsigned nloc = b.st[0], nx = b.st[1];
    if (nloc == 0u) { xcd_barrier_complete(bar, b.x, nloc, nx); b.st[0] = nloc; b.st[1] = nx; }
    const unsigned old = xb_add(&bar[XB_XSUB(b.x)], 1u);
    const unsigned gen = old / nloc;
    if (old + 1u == (gen + 1u) * nloc) {
      __builtin_amdgcn_fence(__ATOMIC_RELEASE, "agent");
      asm volatile("s_waitcnt vmcnt(0)" ::: "memory");
      const unsigned og = xb_add(&bar[XB_TOP], 1u);
      const unsigned tg = og / nx;
      if (og + 1u == (tg + 1u) * nx) xb_add(&bar[XB_TOPGEN], 1u);
      else XB_SPIN(xb_ld(&bar[XB_TOPGEN]) == tg, bar);
      __builtin_amdgcn_fence(__ATOMIC_ACQUIRE, "agent");
      xb_add(&bar[XB_XGEN(b.x)], 1u);
      asm volatile("s_waitcnt vmcnt(0)" ::: "memory");
    } else {
      XB_SPIN(xb_ld(&bar[XB_XGEN(b.x)]) == gen, bar);
      __builtin_amdgcn_fence(__ATOMIC_ACQUIRE, "agent");
      asm volatile("s_waitcnt vmcnt(0)" ::: "memory");
    }
  }
  __syncthreads();
}

__shared__ int s_vb;
__shared__ uint4 xb_words;
__global__ void __launch_bounds__(256, 2) fwd_megakernel(Params p) {
  __shared__ __attribute__((aligned(16))) char smem[SMEM_BYTES];
  if (p.bar == nullptr) cg::this_grid().sync();
  if (threadIdx.x == 0) xb_words = make_uint4(0u, 0u, 0u, 0u);
  __syncthreads();
  XcdBarrier xb = xcd_barrier_post(p.bar, (volatile LAS unsigned*)&xb_words);
  int xloc = 0;
  if (threadIdx.x == 0) xloc = atomicAdd(p.ctr + 16 + (int)(xb.x & 7u), 1);
  run_phase<0>(p, smem, blockIdx.x); xcd_barrier(xb);
#if defined(REP_PHASE) && REP_PHASE == 0
  run_phase<0>(p, smem, blockIdx.x); xcd_barrier(xb);
#endif
  if (threadIdx.x == 0) {
    bool even = (gridDim.x & 7) == 0;
    for (int i = 0; i < 8; ++i) even = even && (__hip_atomic_load(p.ctr + 16 + i, __ATOMIC_RELAXED, __HIP_MEMORY_SCOPE_AGENT) == (int)(gridDim.x >> 3));
    s_vb = even ? xloc * 8 + (int)(xb.x & 7u) : (int)blockIdx.x;
  }
  __syncthreads();
  const int vb = s_vb;
  run_phase<1>(p, smem, vb); xcd_barrier(xb);
#if defined(REP_PHASE) && REP_PHASE == 1
  run_phase<1>(p, smem, vb, 8); xcd_barrier(xb);
#endif
  run_phase<2>(p, smem, vb); xcd_barrier(xb);
#if defined(REP_PHASE) && REP_PHASE == 2
  run_phase<2>(p, smem, vb, 8); xcd_barrier(xb);
#endif
  run_phase<3>(p, smem, vb); xcd_barrier(xb);
#if defined(REP_PHASE) && REP_PHASE == 3
  run_phase<3>(p, smem, vb, 8); xcd_barrier(xb);
#endif
  run_phase<4>(p, smem, vb); xcd_barrier(xb);
#if defined(REP_PHASE) && REP_PHASE == 4
  run_phase<4>(p, smem, vb, 8); xcd_barrier(xb);
#endif
  run_phase<5>(p, smem, vb); xcd_barrier(xb);
#if defined(REP_PHASE) && REP_PHASE == 5
  run_phase<5>(p, smem, vb, 8); xcd_barrier(xb);
#endif
  run_phase<6>(p, smem, vb); xcd_barrier(xb);
#if defined(REP_PHASE) && REP_PHASE == 6
  run_phase<6>(p, smem, vb, 8); xcd_barrier(xb);
#endif
  run_phase<7>(p, smem, vb); xcd_barrier(xb);
#if defined(REP_PHASE) && REP_PHASE == 7
  run_phase<7>(p, smem, vb, 8); xcd_barrier(xb);
#endif
  run_phase<8>(p, smem, vb); xcd_barrier(xb);
#if defined(REP_PHASE) && REP_PHASE == 8
  run_phase<8>(p, smem, vb, 8); xcd_barrier(xb);
#endif
  run_phase<9>(p, smem, vb);
}

extern "C" void kernel_launch(void* const* d_in, const int* in_sizes, int n_in, void* d_out, int out_size, void* d_ws, size_t ws_size, hipStream_t stream) {
  static int grid_blocks = 0;
  if (!grid_blocks) {
    int dev = 0, cus = 0, per_cu = 0;
    (void)hipGetDevice(&dev);
    (void)hipDeviceGetAttribute(&cus, hipDeviceAttributeMultiprocessorCount, dev);
    (void)hipOccupancyMaxActiveBlocksPerMultiprocessor(&per_cu, fwd_megakernel, 256, 0);
    if (per_cu < 1) per_cu = 1;
    if (per_cu > 2) per_cu = 2;
    grid_blocks = cus * per_cu;
  }
  Params p{};
  const float* const* in = (const float* const*)d_in;
  p.x_prompt = in[0]; p.x_sample = in[1]; p.st_s5_re = in[2]; p.st_s5_im = in[3]; p.st_gdn = in[4]; p.st_gdn_conv = in[5]; p.st_ffn_conv = in[6];
  p.norm1_g = in[7]; p.w_in = in[8]; p.a_re = in[9]; p.a_im = in[10]; p.log_dt = in[11]; p.b_re = in[12]; p.b_im = in[13]; p.c_re = in[14]; p.c_im = in[15];
  p.s5_d = in[16]; p.w_glu = in[17]; p.gdn_conv_w = in[18]; p.a_log = in[19]; p.dt_bias = in[20]; p.onorm_g = in[21]; p.w_out = in[22]; p.norm2_g = in[23];
  p.w_up = in[24]; p.ffn_conv_w = in[25]; p.w_down = in[26]; p.normf_g = in[27];
  float* o = (float*)d_out;
  p.out = o;
  size_t off = (size_t)MROWS * 1024;
  p.p_s5_re = o + off; off += 8 * 32 * 64;
  p.p_s5_im = o + off; off += 8 * 32 * 64;
  p.p_gdn = o + off; off += (size_t)8 * 4 * 128 * 128;
  p.p_gdn_conv = o + off; off += 8 * 3 * 1536;
  p.p_ffn_conv = o + off; off += 8 * 2 * 5632;
  p.s_s5_re = o + off; off += 128 * 32 * 64;
  p.s_s5_im = o + off; off += 128 * 32 * 64;
  p.s_gdn = o + off; off += (size_t)128 * 4 * 128 * 128;
  p.s_gdn_conv = o + off; off += 128 * 3 * 1536;
  p.s_ffn_conv = o + off; off += 128 * 2 * 5632;
  p.ogdn = o;
  p.ys5 = (bf16_t*)(o + (size_t)NTOK * 512);
  char* ws = (char*)d_ws;
  size_t wo = 0;
  auto take = [&](size_t bytes) { char* r = ws + wo; wo += (bytes + 255) & ~(size_t)255; return r; };
  p.ctr = (int*)take(256);
  p.bar = (unsigned*)take(XCD_BAR_WORDS * 4);
  p.ba = (float*)take((size_t)MROWS * 8 * 4);
  p.glast = (float*)take(1024 * 4);
  p.sproj = (float*)take((size_t)128 * NPROJ * 4);
  p.WinT = (bf16_t*)take((size_t)2560 * 1024 * 2);
  p.WgluT = (bf16_t*)take((size_t)1024 * 512 * 2);
  p.WoutT = (bf16_t*)take((size_t)1024 * 1024 * 2);
  p.WupT = (bf16_t*)take((size_t)5632 * 1024 * 2);
  p.WdnT = (bf16_t*)take((size_t)1024 * 2816 * 2);
  p.XN = (bf16_t*)take((size_t)MROWS * 1024 * 2);
  p.PROJ = (bf16_t*)take((size_t)MROWS * NPROJ * 2);
  p.ACT = p.PROJ;
  p.GDNI = (bf16_t*)take((size_t)1024 * 36864 * 2);
  if (wo > ws_size) { fprintf(stderr, "workspace too small: need %zu have %zu\n", wo, ws_size); return; }
  (void)hipMemsetAsync(p.ctr, 0, 256 + ((XCD_BAR_WORDS * 4 + 255) & ~255), stream);
#if MK_MULTI
  phase_kernel<0><<<grid_blocks, 256, 0, stream>>>(p);
  phase_kernel<1><<<grid_blocks, 256, 0, stream>>>(p);
  phase_kernel<2><<<grid_blocks, 256, 0, stream>>>(p);
  phase_kernel<3><<<grid_blocks, 256, 0, stream>>>(p);
  phase_kernel<4><<<grid_blocks, 256, 0, stream>>>(p);
  phase_kernel<5><<<grid_blocks, 256, 0, stream>>>(p);
  phase_kernel<6><<<grid_blocks, 256, 0, stream>>>(p);
  phase_kernel<7><<<grid_blocks, 256, 0, stream>>>(p);
  phase_kernel<8><<<grid_blocks, 256, 0, stream>>>(p);
  phase_kernel<9><<<grid_blocks, 256, 0, stream>>>(p);
#else
  void* args[] = {&p};
  hipError_t e = hipLaunchCooperativeKernel((void*)fwd_megakernel, dim3(grid_blocks), dim3(256), args, 0, stream);
  if (e != hipSuccess) fprintf(stderr, "cooperative launch failed: %s (grid %d)\n", hipGetErrorString(e), grid_blocks);
#endif
}
```

```cpp
#include <hip/hip_runtime.h>
#include <hip/hip_cooperative_groups.h>
#include <cstdio>
namespace cg = cooperative_groups;

#ifndef MK_MULTI
#define MK_MULTI 0
#endif

typedef unsigned short bf16_t;
using bf16x8 = __attribute__((ext_vector_type(8))) short;
using f32x4 = __attribute__((ext_vector_type(4))) float;
using u32x4 = __attribute__((ext_vector_type(4))) unsigned;

#define DI __device__ __forceinline__

typedef __bf16 bf16x2_t __attribute__((ext_vector_type(2)));
typedef float f32x2_t __attribute__((ext_vector_type(2)));
DI bf16_t f2bf(float x) { __bf16 h = (__bf16)x; return __builtin_bit_cast(bf16_t, h); }
DI float bf2f(bf16_t b) { return __uint_as_float(((unsigned)b) << 16); }
DI unsigned pack2(float a, float b) { f32x2_t v = {a, b}; bf16x2_t r = __builtin_convertvector(v, bf16x2_t); return __builtin_bit_cast(unsigned, r); }
DI float bflo(unsigned u) { return __uint_as_float(u << 16); }
DI float bfhi(unsigned u) { return __uint_as_float(u & 0xffff0000u); }
DI float sigmoidf_(float x) { return 1.f / (1.f + __expf(-x)); }
DI float siluf_(float x) { return x / (1.f + __expf(-x)); }
DI float geluf_(float x) { float u = 0.7978845608028654f * (x + 0.044715f * x * x * x); float th = 1.f - 2.f / (1.f + __expf(2.f * u)); return 0.5f * x * (1.f + th); }
DI float wave_sum(float v) { for (int o = 32; o > 0; o >>= 1) v += __shfl_xor(v, o); return v; }
DI f32x4 mfma16(bf16x8 a, bf16x8 b, f32x4 c) { return __builtin_amdgcn_mfma_f32_16x16x32_bf16(a, b, c, 0, 0, 0); }

constexpr int NTOK = 16384;
constexpr int MROWS = 16512;
constexpr int NPROJ = 2560;
constexpr int SMEM_BYTES = 67584;

struct Params {
  const float *x_prompt, *x_sample, *st_s5_re, *st_s5_im, *st_gdn, *st_gdn_conv, *st_ffn_conv;
  const float *norm1_g, *w_in, *a_re, *a_im, *log_dt, *b_re, *b_im, *c_re, *c_im, *s5_d, *w_glu;
  const float *gdn_conv_w, *a_log, *dt_bias, *onorm_g, *w_out, *norm2_g, *w_up, *ffn_conv_w, *w_down, *normf_g;
  float *out;
  float *p_s5_re, *p_s5_im, *p_gdn, *p_gdn_conv, *p_ffn_conv, *s_s5_re, *s_s5_im, *s_gdn, *s_gdn_conv, *s_ffn_conv;
  float *ogdn;
  bf16_t *ys5;
  int *ctr; unsigned *bar; float *ba; float *glast; float *sproj;
  bf16_t *WinT, *WgluT, *WoutT, *WupT, *WdnT, *XN, *PROJ, *GDNI, *ACT;
};

DI const float* xin_row(const Params& p, int row) {
  return row < NTOK ? p.x_prompt + (size_t)row * 1024 : p.x_sample + (size_t)(row - NTOK) * 1024;
}

__shared__ int s_item;
DI int fetch_item(int* ctr) {
  __syncthreads();
  if (threadIdx.x == 0) s_item = atomicAdd(ctr, 1);
  __syncthreads();
  return s_item;
}

DI void lds_barrier() { asm volatile("s_waitcnt lgkmcnt(0)\n\ts_barrier" ::: "memory"); }

DI float block_sum(float v, float* red) {
  v = wave_sum(v);
  __syncthreads();
  if ((threadIdx.x & 63) == 0) red[threadIdx.x >> 6] = v;
  __syncthreads();
  return red[0] + red[1] + red[2] + red[3];
}

DI void transpose_item(const float* src, int ldsrc, int srccol0, int k0, bf16_t* dst, int lddst, int r0, float* tl) {
  const int t = threadIdx.x;
  float v[4][8];
  { const int jj = t & 31, kk = t >> 5;
#pragma unroll
    for (int kb = 0; kb < 4; ++kb)
#pragma unroll
      for (int i = 0; i < 8; ++i) v[kb][i] = src[(size_t)(k0 + kb * 64 + kk + 8 * i) * ldsrc + srccol0 + jj]; }
#pragma unroll
  for (int kb = 0; kb < 4; ++kb) {
    { const int jj = t & 31, kk = t >> 5;
#pragma unroll
      for (int i = 0; i < 8; ++i) tl[(kk + 8 * i) * 33 + jj] = v[kb][i]; }
    __syncthreads();
    { const int kk = t & 63, jj = t >> 6;
#pragma unroll
      for (int i = 0; i < 8; ++i) dst[(size_t)(r0 + jj + 4 * i) * lddst + k0 + kb * 64 + kk] = f2bf(tl[kk * 33 + jj + 4 * i]); }
    __syncthreads();
  }
}

DI int perm_col(int r0, int halfoff) {
  const int tt = r0 >> 7, rr = r0 & 127, wn = rr >> 6, half = (rr >> 5) & 1;
  return half * halfoff + tt * 64 + wn * 32;
}

__device__ void phase0(const Params& p, char* smem) {
  float* wt = (float*)smem;
  float* tl = (float*)(smem + 32768);
  for (int i = threadIdx.x; i < 8192; i += 256) { const int k = i >> 3, j = i & 7; wt[j * 1024 + k] = p.w_in[(size_t)k * 2568 + 2560 + j]; }
  __syncthreads();
  for (int i = blockIdx.x * 256 + threadIdx.x; i < 128 * NPROJ / 4; i += gridDim.x * 256) *(float4*)(p.sproj + (size_t)i * 4) = make_float4(0.f, 0.f, 0.f, 0.f);
  constexpr int NT_IN = 320, NT_GLU = 64, NT_OUT = 128, NT_UP = 704, NT_DN = 352;
  constexpr int nT = NT_IN + NT_GLU + NT_OUT + NT_UP + NT_DN;
  constexpr int nRow = MROWS / 8;
  for (int it = blockIdx.x; it < nT + nRow; it += gridDim.x) {
    if (it < nT) {
      int i = it;
      if (i < NT_IN) { const int r0 = (i >> 2) * 32, k0 = (i & 3) * 256; transpose_item(p.w_in, 2568, r0, k0, p.WinT, 1024, r0, tl); continue; }
      i -= NT_IN;
      if (i < NT_GLU) { const int r0 = (i >> 1) * 32, k0 = (i & 1) * 256; transpose_item(p.w_glu, 1024, perm_col(r0, 512), k0, p.WgluT, 512, r0, tl); continue; }
      i -= NT_GLU;
      if (i < NT_OUT) { const int r0 = (i >> 2) * 32, k0 = (i & 3) * 256; transpose_item(p.w_out, 1024, r0, k0, p.WoutT, 1024, r0, tl); continue; }
      i -= NT_OUT;
      if (i < NT_UP) { const int r0 = (i >> 2) * 32, k0 = (i & 3) * 256; transpose_item(p.w_up, 5632, perm_col(r0, 2816), k0, p.WupT, 1024, r0, tl); continue; }
      i -= NT_UP;
      { const int r0 = (i / 11) * 32, k0 = (i % 11) * 256; transpose_item(p.w_down, 1024, r0, k0, p.WdnT, 2816, r0, tl); }
    } else {
      const int lane = threadIdx.x & 63, w = threadIdx.x >> 6;
      float4 v2[2][4];
#pragma unroll
      for (int rr = 0; rr < 2; ++rr) {
        const float* xr = xin_row(p, (it - nT) * 8 + rr * 4 + w);
#pragma unroll
        for (int i = 0; i < 4; ++i) v2[rr][i] = *(const float4*)(xr + i * 256 + lane * 4);
      }
#pragma unroll
      for (int rr = 0; rr < 2; ++rr) {
        const int row = (it - nT) * 8 + rr * 4 + w;
        float4 v[4]; float ss = 0.f;
#pragma unroll
        for (int i = 0; i < 4; ++i) { v[i] = v2[rr][i]; ss += v[i].x * v[i].x + v[i].y * v[i].y + v[i].z * v[i].z + v[i].w * v[i].w; }
        ss = wave_sum(ss);
        const float rstd = rsqrtf(ss * (1.f / 1024.f) + 1e-6f);
        float acc[8];
#pragma unroll
        for (int j = 0; j < 8; ++j) acc[j] = 0.f;
#pragma unroll
        for (int i = 0; i < 4; ++i) {
          const float4 g = *(const float4*)(p.norm1_g + i * 256 + lane * 4);
          v[i].x *= rstd * g.x; v[i].y *= rstd * g.y; v[i].z *= rstd * g.z; v[i].w *= rstd * g.w;
          uint2 pk; pk.x = pack2(v[i].x, v[i].y); pk.y = pack2(v[i].z, v[i].w);
          *(uint2*)(p.XN + (size_t)row * 1024 + i * 256 + lane * 4) = pk;
#pragma unroll
          for (int j = 0; j < 8; ++j) { const float4 wv = *(const float4*)(wt + j * 1024 + i * 256 + lane * 4); acc[j] += v[i].x * wv.x + v[i].y * wv.y + v[i].z * wv.z + v[i].w * wv.w; }
        }
#pragma unroll
        for (int j = 0; j < 8; ++j) acc[j] = wave_sum(acc[j]);
        if (lane == 0) {
          *(float4*)(p.ba + (size_t)row * 8) = make_float4(acc[0], acc[1], acc[2], acc[3]);
          *(float4*)(p.ba + (size_t)row * 8 + 4) = make_float4(acc[4], acc[5], acc[6], acc[7]);
        }
      }
    }
  }
}

template <bool NULLCHK, int PMODE = 0>
DI void gemm_main(const bf16_t* a0, size_t astr, unsigned amask, const bf16_t* b0, size_t bstr, int nk, f32x4 (&acc)[4][4], char* smem) {
  char* As = smem;
  char* Bs = smem + 16384;
  const int t = threadIdx.x, lane = t & 63, w = t >> 6, wm = w >> 1, wn = w & 1, r = lane & 15, q = lane >> 4;
  const u32x4 z4 = u32x4{0u, 0u, 0u, 0u};
  u32x4 ra0[4], rb0[4];
  const int soff = (t >> 3) * 128 + (((t & 7) ^ ((t >> 3) & 7)) * 16);
  const int aoff = (wm * 64 + r) * 128, boff = (wn * 64 + r) * 128;
  const int sw0 = ((q) ^ (r & 7)) * 16, sw1 = ((4 + q) ^ (r & 7)) * 16;
#define G_LOAD(RA, RB, KT) _Pragma("unroll") for (int i = 0; i < 4; ++i) { \
    RA[i] = (!NULLCHK || ((amask >> i) & 1u)) ? *(const u32x4*)(a0 + i * astr + (KT) * 64) : z4; \
    RB[i] = *(const u32x4*)(b0 + i * bstr + (KT) * 64); }
#define G_STORE(RA, RB) _Pragma("unroll") for (int i = 0; i < 4; ++i) { \
    *(u32x4*)(As + soff + i * 4096) = RA[i]; \
    *(u32x4*)(Bs + soff + i * 4096) = RB[i]; }
#define G_COMPUTE() _Pragma("unroll") for (int ks = 0; ks < 2; ++ks) { \
    bf16x8 af[4], bfr[4]; \
    _Pragma("unroll") for (int mi = 0; mi < 4; ++mi) af[mi] = *(const bf16x8*)(As + aoff + mi * 2048 + (ks ? sw1 : sw0)); \
    _Pragma("unroll") for (int ni = 0; ni < 4; ++ni) bfr[ni] = *(const bf16x8*)(Bs + boff + ni * 2048 + (ks ? sw1 : sw0)); \
    __builtin_amdgcn_s_setprio(1); \
    _Pragma("unroll") for (int mi = 0; mi < 4; ++mi) _Pragma("unroll") for (int ni = 0; ni < 4; ++ni) acc[mi][ni] = mfma16(bfr[ni], af[mi], acc[mi][ni]); \
    __builtin_amdgcn_s_setprio(0); }
  G_LOAD(ra0, rb0, 0)
#pragma unroll
  for (int mi = 0; mi < 4; ++mi)
#pragma unroll
    for (int ni = 0; ni < 4; ++ni) acc[mi][ni] = f32x4{0.f, 0.f, 0.f, 0.f};
  for (int kt = 0; kt < nk; ++kt) {
    if (kt == 0) __syncthreads(); else lds_barrier();
    G_STORE(ra0, rb0)
    lds_barrier();
    if (PMODE != 1 && kt + 1 < nk) { G_LOAD(ra0, rb0, kt + 1) }
    __builtin_amdgcn_sched_barrier(0);
    G_COMPUTE()
  }
#undef G_LOAD
#undef G_STORE
#undef G_COMPUTE
}

template <int PMODE = 0>
DI void gemm_std(const bf16_t* A, int lda, int m0, const bf16_t* Bt, int ldb, int n0, int nk, f32x4 (&acc)[4][4], char* smem) {
  const int t = threadIdx.x;
  const bf16_t* a0 = A + (size_t)(m0 + (t >> 3)) * lda + (t & 7) * 8;
  const bf16_t* b0 = Bt + (size_t)(n0 + (t >> 3)) * ldb + (t & 7) * 8;
  gemm_main<false, PMODE>(a0, (size_t)32 * lda, 0xfu, b0, (size_t)32 * ldb, nk, acc, smem);
}

DI bool get_tile(int vb, int step, int MT, int NT, int GW, int& mt, int& nt, bool& valid) {
  const int G = gridDim.x;
  if ((G & 7) == 0 && ((G >> 3) % GW) == 0) {
    const int xcd = vb & 7, local = vb >> 3, GH = (G >> 3) / GW;
    const int NGN = (NT + GW - 1) / GW, NGM = (MT + GH - 1) / GH;
    const int g = step * 8 + xcd;
    if (g >= NGN * NGM) return false;
    mt = (g / NGN) * GH + local / GW; nt = (g % NGN) * GW + local % GW;
    valid = mt < MT && nt < NT;
    return true;
  }
  const int idx = vb + step * G;
  if (idx >= MT * NT) return false;
  mt = idx / NT; nt = idx % NT; valid = true;
  return true;
}

DI bool get_tile_strip(int vb, int step, int MT, int NT, int GW, int& mt, int& nt) {
  const int G = gridDim.x, T = MT * NT;
  int idx;
  if ((G & 7) == 0) {
    const int xcd = vb & 7, local = vb >> 3, lpx = G >> 3;
    const int start = (int)(((long)T * xcd) >> 3), end = (int)(((long)T * (xcd + 1)) >> 3);
    idx = start + local + lpx * step;
    if (idx >= end) return false;
  } else {
    idx = vb + step * G;
    if (idx >= T) return false;
  }
  const int strip = idx / (MT * GW), rem = idx % (MT * GW);
  mt = rem / GW; nt = strip * GW + rem % GW;
  return true;
}

#define EPI_COORDS const int t = threadIdx.x, lane = t & 63, w = t >> 6, wm = w >> 1, wn = w & 1, r = lane & 15, q = lane >> 4; (void)wm; (void)wn; (void)r; (void)q;

DI void sample_splitk_task(float* obase, int ldo, const bf16_t* A, int lda, const bf16_t* Bt, int ldb, int nt, int ks, char* smem) {
  f32x4 acc[4][4];
  gemm_std(A + (size_t)ks * 256, lda, NTOK, Bt + (size_t)ks * 256, ldb, nt * 128, 4, acc, smem);
  EPI_COORDS
#pragma unroll
  for (int mi = 0; mi < 4; ++mi)
#pragma unroll
    for (int ni = 0; ni < 4; ++ni) {
      float* o = obase + (size_t)(wm * 64 + mi * 16 + r) * ldo + nt * 128 + wn * 64 + ni * 16 + q * 4;
#pragma unroll
      for (int j = 0; j < 4; ++j) unsafeAtomicAdd(o + j, acc[mi][ni][j]);
    }
}

#ifndef REP_MODE
#define REP_MODE 0
#endif
template <int PMODE>
DI void phase1(const Params& p, char* smem, int vb) {
  constexpr int NT = 20, MT = 128;
  if (PMODE == 0 && vb < 80) sample_splitk_task(p.sproj, NPROJ, p.XN, 1024, p.WinT, 1024, vb % 20, vb / 20, smem);
  for (int step = 0;; ++step) {
    int mt, nt;
    if (!get_tile_strip(vb, step, MT, NT, 4, mt, nt)) break;
    f32x4 acc[4][4];
    if (PMODE == 2) gemm_std<0>(p.XN, 1024, 0, p.WinT, 1024, 0, 16, acc, smem);
    else gemm_std<PMODE>(p.XN, 1024, mt * 128, p.WinT, 1024, nt * 128, 16, acc, smem);
    if (PMODE != 0 && p.ctr[40] == 0) continue;
    EPI_COORDS
#pragma unroll
    for (int mi = 0; mi < 4; ++mi)
#pragma unroll
      for (int ni = 0; ni < 4; ++ni) {
        const int row = mt * 128 + wm * 64 + mi * 16 + r, col = nt * 128 + wn * 64 + ni * 16 + q * 4;
        uint2 pk; pk.x = pack2(acc[mi][ni][0], acc[mi][ni][1]); pk.y = pack2(acc[mi][ni][2], acc[mi][ni][3]);
        *(uint2*)(p.PROJ + (size_t)row * NPROJ + col) = pk;
      }
  }
}

DI void s5_disc(const Params& p, int g, int n, float& abr, float& abi, float& fre, float& fim) {
  const float ar = p.a_re[g * 64 + n], ai = p.a_im[g * 64 + n], dt = expf(p.log_dt[g]);
  const float mag = expf(ar * dt);
  float sn, cs; sincosf(ai * dt, &sn, &cs);
  abr = mag * cs; abi = mag * sn;
  const float den = ar * ar + ai * ai, pp = abr - 1.f;
  fre = (pp * ar + abi * ai) / den; fim = (abi * ar - pp * ai) / den;
}

__device__ void s5_scan_item(const Params& p, int item, char* smem) {
  const int b = item >> 5, g = item & 31;
  float* Xs = (float*)smem;
  bf16_t* Hs = (bf16_t*)(smem + 32768);
  bf16_t* Us = (bf16_t*)(smem + 32768 + 17408);
  const int t = threadIdx.x, lane = t & 63, w = t >> 6, r = lane & 15, q = lane >> 4;
  for (int i = t; i < 64 * 40; i += 256) Us[i] = 0;
  bf16x8 bfrag[2];
#pragma unroll
  for (int x = 0; x < 2; ++x) {
    const int np = (2 * w + x) * 16 + r, n = np >> 1, part = np & 1;
    float abr, abi, fre, fim; s5_disc(p, g, n, abr, abi, fre, fim);
#pragma unroll
    for (int jj = 0; jj < 8; ++jj) {
      float val = 0.f;
      if (q < 2) {
        const int c = q * 8 + jj;
        const float br = p.b_re[(size_t)(g * 64 + n) * 16 + c], bi = p.b_im[(size_t)(g * 64 + n) * 16 + c];
        val = part == 0 ? fre * br - fim * bi : fre * bi + fim * br;
      }
      bfrag[x][jj] = (short)f2bf(val);
    }
  }
  bf16x8 cfrag[4];
#pragma unroll
  for (int ks = 0; ks < 4; ++ks)
#pragma unroll
    for (int jj = 0; jj < 8; ++jj) {
      const int k = ks * 32 + q * 8 + jj;
      const float val = (k & 1) == 0 ? p.c_re[(size_t)(g * 16 + r) * 64 + (k >> 1)] : -p.c_im[(size_t)(g * 16 + r) * 64 + (k >> 1)];
      cfrag[ks][jj] = (short)f2bf(val);
    }
  float abr, abi, hr = 0.f, hi = 0.f;
  { float fre, fim; s5_disc(p, g, lane, abr, abi, fre, fim); }
  const float dcoef = p.s5_d[g * 16 + r];
  __syncthreads();
  u32x4 unext = u32x4{0u, 0u, 0u, 0u};
  if (t < 128) unext = *(const u32x4*)(p.PROJ + ((size_t)b * 2048 + (t >> 1)) * NPROJ + g * 16 + (t & 1) * 8);
  for (int ch = 0; ch < 32; ++ch) {
    const size_t tok0 = (size_t)b * 2048 + ch * 64;
    if (t < 128) {
      *(u32x4*)(Us + (t >> 1) * 40 + (t & 1) * 8) = unext;
      if (ch + 1 < 32) unext = *(const u32x4*)(p.PROJ + (tok0 + 64 + (t >> 1)) * NPROJ + g * 16 + (t & 1) * 8);
    }
    lds_barrier();
    {
      bf16x8 af[4];
#pragma unroll
      for (int mt = 0; mt < 4; ++mt) af[mt] = *(const bf16x8*)(Us + (mt * 16 + r) * 40 + q * 8);
#pragma unroll
      for (int x = 0; x < 2; ++x)
#pragma unroll
        for (int mt = 0; mt < 4; ++mt) {
          f32x4 z = f32x4{0.f, 0.f, 0.f, 0.f};
          z = mfma16(af[mt], bfrag[x], z);
          const int col = (2 * w + x) * 16 + r;
#pragma unroll
          for (int j = 0; j < 4; ++j) Xs[(mt * 16 + q * 4 + j) * 128 + col] = z[j];
        }
    }
    lds_barrier();
    if (w == 0) {
      for (int tb = 0; tb < 8; ++tb) {
        f32x2_t xv[8];
#pragma unroll
        for (int u = 0; u < 8; ++u) xv[u] = *(const f32x2_t*)(Xs + (tb * 8 + u) * 128 + 2 * lane);
#pragma unroll
        for (int u = 0; u < 8; ++u) {
          const float nr = abr * hr - abi * hi + xv[u][0], ni = abr * hi + abi * hr + xv[u][1];
          hr = nr; hi = ni;
          *(unsigned*)(Hs + (tb * 8 + u) * 136 + 2 * lane) = pack2(hr, hi);
        }
      }
    }
    lds_barrier();
    {
      f32x4 y = f32x4{0.f, 0.f, 0.f, 0.f};
#pragma unroll
      for (int ks = 0; ks < 4; ++ks) { const bf16x8 a = *(const bf16x8*)(Hs + (w * 16 + r) * 136 + ks * 32 + q * 8); y = mfma16(a, cfrag[ks], y); }
#pragma unroll
      for (int j = 0; j < 4; ++j) {
        const int tk = w * 16 + q * 4 + j;
        const float u = bf2f(Us[tk * 40 + r]);
        p.ys5[(tok0 + tk) * 512 + g * 16 + r] = f2bf(geluf_(y[j] + dcoef * u));
      }
    }
    lds_barrier();
  }
  if (w == 0) { p.p_s5_re[(size_t)(b * 32 + g) * 64 + lane] = hr; p.p_s5_im[(size_t)(b * 32 + g) * 64 + lane] = hi; }
}

__device__ void s5_decode_item(const Params& p, int s, char* smem) {
  float* us = (float*)smem; float* hre = us + 512; float* him = hre + 2048;
  const int t = threadIdx.x; const size_t row = NTOK + s;
  __syncthreads();
  for (int i = t; i < 512; i += 256) us[i] = p.sproj[(size_t)s * NPROJ + i];
  __syncthreads();
  for (int gq = 0; gq < 8; ++gq) {
    const int g = gq * 4 + (t >> 6), n = t & 63;
    float abr, abi, fre, fim; s5_disc(p, g, n, abr, abi, fre, fim);
    const float* br = p.b_re + (size_t)(g * 64 + n) * 16; const float* bi = p.b_im + (size_t)(g * 64 + n) * 16;
    float bur = 0.f, bui = 0.f;
#pragma unroll
    for (int c = 0; c < 16; ++c) { const float u = us[g * 16 + c]; bur += br[c] * u; bui += bi[c] * u; }
    const float xr = fre * bur - fim * bui, xi = fre * bui + fim * bur;
    const size_t si = (size_t)(s * 32 + g) * 64 + n;
    const float h0r = p.st_s5_re[si], h0i = p.st_s5_im[si];
    const float hr = abr * h0r - abi * h0i + xr, hi = abr * h0i + abi * h0r + xi;
    p.s_s5_re[si] = hr; p.s_s5_im[si] = hi;
    hre[g * 64 + n] = hr; him[g * 64 + n] = hi;
  }
  __syncthreads();
  for (int o = t; o < 512; o += 256) {
    const int g = o >> 4;
    const float* cr = p.c_re + (size_t)o * 64; const float* ci = p.c_im + (size_t)o * 64;
    float y = 0.f;
    for (int n = 0; n < 64; ++n) y += cr[n] * hre[g * 64 + n] - ci[n] * him[g * 64 + n];
    y += p.s5_d[o] * us[o];
    p.ys5[row * 512 + o] = f2bf(geluf_(y));
  }
  __syncthreads();
}

__device__ void gdn_prep_item(const Params& p, int item, char* smem) {
  const int c = item & 31, h = (item >> 5) & 3, b = item >> 7;
  bf16_t* Kn = (bf16_t*)smem;
  bf16_t* Qn = (bf16_t*)(smem + 16384);
  float* Lm = (float*)(smem + 16384);
  bf16_t* Vs = (bf16_t*)(smem + 32768);
  float* gcs = (float*)(smem + 49152);
  float* bts = gcs + 64;
  float* egs = bts + 64;
  const int t = threadIdx.x, lane = t & 63, w = t >> 6, r = lane & 15, q = lane >> 4;
  const int tok0 = c * 64; const size_t row0 = (size_t)b * 2048 + tok0;
  bf16_t* gi = p.GDNI + (size_t)item * 36864;
  __syncthreads();
  if (w == 0) {
    const float* bar = p.ba + (row0 + lane) * 8;
    const float beta = sigmoidf_(bar[h]);
    const float xx = bar[4 + h] + p.dt_bias[h];
    const float sp = fmaxf(xx, 0.f) + log1pf(expf(-fabsf(xx)));
    float s = -expf(p.a_log[h]) * sp;
    for (int o = 1; o < 64; o <<= 1) { const float y = __shfl_up(s, o); if (lane >= o) s += y; }
    gcs[lane] = s; bts[lane] = beta; egs[lane] = expf(s);
  }
  __syncthreads();
  if (c == 31) {
    for (int idx = t; idx < 1152; idx += 256) {
      const int i = idx / 384, rem = idx % 384, X = rem >> 7, cc = rem & 127;
      const int col = X * 512 + h * 128 + cc;
      p.p_gdn_conv[(size_t)(b * 3 + i) * 1536 + col] = bf2f(p.PROJ[((size_t)b * 2048 + 2045 + i) * NPROJ + 512 + col]);
    }
  }
  {
    const int row = t >> 2, seg = t & 3;
    const float eg = egs[row], ekg = expf(gcs[63] - gcs[row]);
    const int tok = tok0 + row;
#pragma unroll
    for (int X = 0; X < 3; ++X) {
      float val[32]; float ss = 0.f;
      const int colbase = X * 512 + h * 128 + seg * 32;
#pragma unroll
      for (int cb = 0; cb < 4; ++cb) {
        float a8[8];
#pragma unroll
        for (int e = 0; e < 8; ++e) a8[e] = 0.f;
#pragma unroll
        for (int tap = 0; tap < 4; ++tap) {
          const int tk = tok - 3 + tap;
          if (tk >= 0) {
            const uint4 raw = *(const uint4*)(p.PROJ + ((size_t)b * 2048 + tk) * NPROJ + 512 + colbase + cb * 8);
            const float* wp = p.gdn_conv_w + tap * 1536 + colbase + cb * 8;
            const float4 w0 = *(const float4*)wp, w1 = *(const float4*)(wp + 4);
            a8[0] += bflo(raw.x) * w0.x; a8[1] += bfhi(raw.x) * w0.y; a8[2] += bflo(raw.y) * w0.z; a8[3] += bfhi(raw.y) * w0.w;
            a8[4] += bflo(raw.z) * w1.x; a8[5] += bfhi(raw.z) * w1.y; a8[6] += bflo(raw.w) * w1.z; a8[7] += bfhi(raw.w) * w1.w;
          }
        }
#pragma unroll
        for (int e = 0; e < 8; ++e) { const float v = siluf_(a8[e]); val[cb * 8 + e] = v; ss += v * v; }
        __builtin_amdgcn_sched_barrier(0);
      }
      if (X < 2) {
        ss += __shfl_xor(ss, 1); ss += __shfl_xor(ss, 2);
        const float sc = rsqrtf(ss + 1e-6f) * (X == 0 ? 0.08838834764831845f : 1.f);
#pragma unroll
        for (int e = 0; e < 32; ++e) val[e] *= sc;
      }
      if (X == 0) {
#pragma unroll
        for (int cb = 0; cb < 4; ++cb) {
          uint4 pk; pk.x = pack2(val[cb * 8], val[cb * 8 + 1]); pk.y = pack2(val[cb * 8 + 2], val[cb * 8 + 3]); pk.z = pack2(val[cb * 8 + 4], val[cb * 8 + 5]); pk.w = pack2(val[cb * 8 + 6], val[cb * 8 + 7]);
          *(uint4*)(Qn + row * 128 + (((seg * 4 + cb) ^ (row & 15)) * 8)) = pk;
          uint4 pg; pg.x = pack2(val[cb * 8] * eg, val[cb * 8 + 1] * eg); pg.y = pack2(val[cb * 8 + 2] * eg, val[cb * 8 + 3] * eg); pg.z = pack2(val[cb * 8 + 4] * eg, val[cb * 8 + 5] * eg); pg.w = pack2(val[cb * 8 + 6] * eg, val[cb * 8 + 7] * eg);
          *(uint4*)(gi + 16384 + row * 128 + seg * 32 + cb * 8) = pg;
        }
      } else if (X == 1) {
#pragma unroll
        for (int cb = 0; cb < 4; ++cb) {
          uint4 pk; pk.x = pack2(val[cb * 8], val[cb * 8 + 1]); pk.y = pack2(val[cb * 8 + 2], val[cb * 8 + 3]); pk.z = pack2(val[cb * 8 + 4], val[cb * 8 + 5]); pk.w = pack2(val[cb * 8 + 6], val[cb * 8 + 7]);
          *(uint4*)(Kn + row * 128 + (((seg * 4 + cb) ^ (row & 15)) * 8)) = pk;
        }
#pragma unroll
        for (int e = 0; e < 32; ++e) gi[24576 + (seg * 32 + e) * 64 + row] = f2bf(val[e] * ekg);
      } else {
#pragma unroll
        for (int cb = 0; cb < 4; ++cb) {
          uint4 pk; pk.x = pack2(val[cb * 8], val[cb * 8 + 1]); pk.y = pack2(val[cb * 8 + 2], val[cb * 8 + 3]); pk.z = pack2(val[cb * 8 + 4], val[cb * 8 + 5]); pk.w = pack2(val[cb * 8 + 6], val[cb * 8 + 7]);
          *(uint4*)(Vs + row * 128 + seg * 32 + cb * 8) = pk;
        }
      }
    }
  }
  __syncthreads();
  f32x4 kk[4], qk[4];
  {
    bf16x8 ak[4], aq[4];
    const int rowA = w * 16 + r;
#pragma unroll
    for (int ks = 0; ks < 4; ++ks) { const int phys = (ks * 4 + q) ^ r; ak[ks] = *(const bf16x8*)(Kn + rowA * 128 + phys * 8); aq[ks] = *(const bf16x8*)(Qn + rowA * 128 + phys * 8); }
#pragma unroll
    for (int nt = 0; nt < 4; ++nt) {
      kk[nt] = f32x4{0.f, 0.f, 0.f, 0.f}; qk[nt] = f32x4{0.f, 0.f, 0.f, 0.f};
      if (nt <= w) {
        const int rowB = nt * 16 + r;
#pragma unroll
        for (int ks = 0; ks < 4; ++ks) {
          const int phys = (ks * 4 + q) ^ r;
          const bf16x8 bb = *(const bf16x8*)(Kn + rowB * 128 + phys * 8);
          kk[nt] = mfma16(ak[ks], bb, kk[nt]); qk[nt] = mfma16(aq[ks], bb, qk[nt]);
        }
      }
    }
  }
  __syncthreads();
#pragma unroll
  for (int nt = 0; nt < 4; ++nt)
#pragma unroll
    for (int j = 0; j < 4; ++j) {
      const int i = w * 16 + q * 4 + j, jc = nt * 16 + r;
      const float dec = __expf(fminf(gcs[i] - gcs[jc], 0.f));
      Lm[i * 64 + jc] = (i > jc) ? bts[i] * kk[nt][j] * dec : 0.f;
      gi[32768 + i * 64 + jc] = f2bf((i >= jc) ? qk[nt][j] * dec : 0.f);
    }
  __syncthreads();
  {
    float sol[64];
    const bool isv = t < 128;
    const int kc = t - 128;
    if (isv) {
#pragma unroll
      for (int i = 0; i < 64; ++i) { sol[i] = bf2f(Vs[i * 128 + t]) * bts[i]; if ((i & 7) == 7) __builtin_amdgcn_sched_barrier(0); }
    } else {
#pragma unroll
      for (int i = 0; i < 64; ++i) { sol[i] = bf2f(Kn[i * 128 + (((kc >> 3) ^ (i & 15)) * 8) + (kc & 7)]) * bts[i] * egs[i]; if ((i & 7) == 7) __builtin_amdgcn_sched_barrier(0); }
    }
    __builtin_amdgcn_sched_barrier(0);
#pragma unroll
    for (int i = 1; i < 64; ++i) {
      float a = sol[i];
#pragma unroll
      for (int jb = 0; jb < (i + 3) / 4; ++jb) {
        const float4 l = *(const float4*)(Lm + i * 64 + jb * 4);
        if (jb * 4 + 0 < i) a -= l.x * sol[jb * 4 + 0];
        if (jb * 4 + 1 < i) a -= l.y * sol[jb * 4 + 1];
        if (jb * 4 + 2 < i) a -= l.z * sol[jb * 4 + 2];
        if (jb * 4 + 3 < i) a -= l.w * sol[jb * 4 + 3];
      }
      sol[i] = a;
      __builtin_amdgcn_sched_barrier(0);
    }
    bf16_t* go = gi + t + (isv ? 0 : 8192 - 128);
#pragma unroll
    for (int i = 0; i < 64; ++i) { go[i * 128] = f2bf(sol[i]); if ((i & 7) == 7) __builtin_amdgcn_sched_barrier(0); }
  }
  if (t == 0) p.glast[item] = egs[63];
}

__device__ void gdn_decode_item(const Params& p, int item, char* smem) {
  const int h = item & 3, s = item >> 2; const size_t row = NTOK + s;
  float* qs = (float*)smem; float* ks = qs + 128; float* vs = ks + 128; float* part = vs + 128; float* red = part + 512;
  const int t = threadIdx.x;
  __syncthreads();
  float cv[3] = {0.f, 0.f, 0.f};
  if (t < 128) {
#pragma unroll
    for (int X = 0; X < 3; ++X) {
      const int col = X * 512 + h * 128 + t;
      const float* buf = p.st_gdn_conv + (size_t)s * 3 * 1536 + col;
      const float b0 = buf[0], b1 = buf[1536], b2 = buf[3072];
      const float nw = p.sproj[(size_t)s * NPROJ + 512 + col];
      const float* cw = p.gdn_conv_w + col;
      const float a = b0 * cw[0] + b1 * cw[1536] + b2 * cw[3072] + nw * cw[4608];
      cv[X] = siluf_(a);
      float* ob = p.s_gdn_conv + (size_t)s * 3 * 1536 + col;
      ob[0] = b1; ob[1536] = b2; ob[3072] = nw;
    }
  }
  const float sq = block_sum(cv[0] * cv[0], red), sk = block_sum(cv[1] * cv[1], red);
  const float qn = cv[0] * rsqrtf(sq + 1e-6f) * 0.08838834764831845f, kn = cv[1] * rsqrtf(sk + 1e-6f);
  const float qk = block_sum(qn * kn, red);
  if (t < 128) { qs[t] = qn; ks[t] = kn; vs[t] = cv[2]; }
  const float beta = sigmoidf_(p.ba[row * 8 + h]);
  const float xx = p.ba[row * 8 + 4 + h] + p.dt_bias[h];
  const float eg = expf(-expf(p.a_log[h]) * (fmaxf(xx, 0.f) + log1pf(expf(-fabsf(xx)))));
  __syncthreads();
  const int e = t & 127, dh = t >> 7;
  const size_t soff = ((size_t)(s * 4 + h) * 128 + dh * 64) * 128 + e;
  const float* S0 = p.st_gdn + soff;
  float sr[64]; float kS = 0.f, qS = 0.f;
#pragma unroll
  for (int d = 0; d < 64; ++d) { sr[d] = S0[(size_t)d * 128]; kS += ks[dh * 64 + d] * sr[d]; qS += qs[dh * 64 + d] * sr[d]; }
  part[dh * 128 + e] = kS; part[256 + dh * 128 + e] = qS;
  __syncthreads();
  kS = part[e] + part[128 + e]; qS = part[256 + e] + part[384 + e];
  const float vn = beta * (vs[e] - eg * kS);
  const float o = eg * qS + qk * vn;
  float* S1 = p.s_gdn + soff;
#pragma unroll
  for (int d = 0; d < 64; ++d) S1[(size_t)d * 128] = sr[d] * eg + ks[dh * 64 + d] * vn;
  const float so = block_sum(dh == 0 ? o * o : 0.f, red);
  if (dh == 0) {
    const float z = p.sproj[(size_t)s * NPROJ + 2048 + h * 128 + e];
    p.XN[row * 1024 + 512 + h * 128 + e] = f2bf(o * rsqrtf(so * (1.f / 128.f) + 1e-6f) * p.onorm_g[e] * siluf_(z));
  }
  __syncthreads();
}

#ifndef REP_MASK
#define REP_MASK 15
#endif
template <int MASK>
DI void phase2(const Params& p, char* smem, int cofs) {
  constexpr int N_S5 = 256, N_PREP = 1024, N_SDEC = 128;
  for (;;) {
    int it = fetch_item(p.ctr + 2 + cofs);
    if (it >= N_S5 + N_PREP + N_SDEC) break;
    if (it < N_S5) { if (MASK & 1) s5_scan_item(p, it, smem); continue; }
    it -= N_S5;
    if (it < N_PREP) { if (MASK & 2) gdn_prep_item(p, it, smem); continue; }
    it -= N_PREP;
    if (MASK & 8) s5_decode_item(p, it, smem);
  }
}

__device__ void gdn_seq_item(const Params& p, int item, char* smem) {
  const int sl = item & 3, h = (item >> 2) & 3, b = item >> 4;
  bf16_t* ST = (bf16_t*)smem;
  bf16_t* VT = (bf16_t*)(smem + 8704);
  const int t = threadIdx.x, lane = t & 63, w = t >> 6, r = lane & 15, q = lane >> 4;
  __syncthreads();
  for (int i = t; i < 32 * 136; i += 256) ST[i] = 0;
  f32x4 sacc[2][2];
#pragma unroll
  for (int mi = 0; mi < 2; ++mi)
#pragma unroll
    for (int ni = 0; ni < 2; ++ni) sacc[mi][ni] = f32x4{0.f, 0.f, 0.f, 0.f};
  bf16x8 W0[4], Q0[4], A0[2], K0[2][2];
  unsigned U0[2][4]; float g0;
  const bf16_t* gbase = p.GDNI + (size_t)((b * 4 + h) * 32) * 36864;
  const float* glb = p.glast + (b * 4 + h) * 32;
#define SEQ_LOAD_WQU(S, C) { \
    const bf16_t* gi_ = gbase + (size_t)(C) * 36864; \
    _Pragma("unroll") for (int ks = 0; ks < 4; ++ks) { \
      W##S[ks] = *(const bf16x8*)(gi_ + 8192 + (w * 16 + r) * 128 + ks * 32 + q * 8); \
      Q##S[ks] = *(const bf16x8*)(gi_ + 16384 + (w * 16 + r) * 128 + ks * 32 + q * 8); } \
    _Pragma("unroll") for (int ni = 0; ni < 2; ++ni) _Pragma("unroll") for (int j = 0; j < 4; ++j) \
      U##S[ni][j] = (unsigned)gi_[(w * 16 + q * 4 + j) * 128 + sl * 32 + ni * 16 + r]; \
    g##S = glb[(C)]; }
#define SEQ_LOAD_AK(S, C) { \
    const bf16_t* gi_ = gbase + (size_t)(C) * 36864; \
    _Pragma("unroll") for (int k2 = 0; k2 < 2; ++k2) { \
      A##S[k2] = *(const bf16x8*)(gi_ + 32768 + (w * 16 + r) * 64 + k2 * 32 + q * 8); \
      _Pragma("unroll") for (int mi = 0; mi < 2; ++mi) K##S[mi][k2] = *(const bf16x8*)(gi_ + 24576 + ((2 * w + mi) * 16 + r) * 64 + k2 * 32 + q * 8); } }
#define SEQ_CHUNK(S, C) { \
    f32x4 vacc[2], oacc[2]; \
    _Pragma("unroll") for (int ni = 0; ni < 2; ++ni) { vacc[ni] = f32x4{0.f, 0.f, 0.f, 0.f}; oacc[ni] = f32x4{0.f, 0.f, 0.f, 0.f}; } \
    _Pragma("unroll") for (int ks = 0; ks < 4; ++ks) { \
      _Pragma("unroll") for (int ni = 0; ni < 2; ++ni) { \
        const bf16x8 bs = *(const bf16x8*)(ST + (ni * 16 + r) * 136 + ks * 32 + q * 8); \
        vacc[ni] = mfma16(W0[ks], bs, vacc[ni]); oacc[ni] = mfma16(bs, Q0[ks], oacc[ni]); } } \
    _Pragma("unroll") for (int ni = 0; ni < 2; ++ni) { \
      float vn[4]; \
      _Pragma("unroll") for (int j = 0; j < 4; ++j) vn[j] = __uint_as_float(U0[ni][j] << 16) - vacc[ni][j]; \
      uint2 pk; pk.x = pack2(vn[0], vn[1]); pk.y = pack2(vn[2], vn[3]); \
      *(uint2*)(VT + (ni * 16 + r) * 72 + w * 16 + q * 4) = pk; } \
    const float gl = g0; \
    __builtin_amdgcn_sched_barrier(0); \
    if ((C) + 1 < 32) SEQ_LOAD_WQU(0, (C) + 1) \
    __builtin_amdgcn_sched_barrier(0); \
    lds_barrier(); \
    bf16x8 bv[2][2]; \
    _Pragma("unroll") for (int ni = 0; ni < 2; ++ni) _Pragma("unroll") for (int k2 = 0; k2 < 2; ++k2) bv[ni][k2] = *(const bf16x8*)(VT + (ni * 16 + r) * 72 + k2 * 32 + q * 8); \
    _Pragma("unroll") for (int k2 = 0; k2 < 2; ++k2) _Pragma("unroll") for (int ni = 0; ni < 2; ++ni) oacc[ni] = mfma16(bv[ni][k2], A0[k2], oacc[ni]); \
    _Pragma("unroll") for (int mi = 0; mi < 2; ++mi) { \
      _Pragma("unroll") for (int ni = 0; ni < 2; ++ni) sacc[mi][ni] *= gl; \
      _Pragma("unroll") for (int k2 = 0; k2 < 2; ++k2) _Pragma("unroll") for (int ni = 0; ni < 2; ++ni) sacc[mi][ni] = mfma16(K0[mi][k2], bv[ni][k2], sacc[mi][ni]); } \
    __builtin_amdgcn_sched_barrier(0); \
    if ((C) + 1 < 32) SEQ_LOAD_AK(0, (C) + 1) \
    __builtin_amdgcn_sched_barrier(0); \
    _Pragma("unroll") for (int ni = 0; ni < 2; ++ni) { \
      float4 o; o.x = oacc[ni][0]; o.y = oacc[ni][1]; o.z = oacc[ni][2]; o.w = oacc[ni][3]; \
      *(float4*)(p.ogdn + ((size_t)b * 2048 + (C) * 64 + w * 16 + r) * 512 + h * 128 + sl * 32 + ni * 16 + q * 4) = o; } \
    _Pragma("unroll") for (int mi = 0; mi < 2; ++mi) _Pragma("unroll") for (int ni = 0; ni < 2; ++ni) { \
      uint2 pk; pk.x = pack2(sacc[mi][ni][0], sacc[mi][ni][1]); pk.y = pack2(sacc[mi][ni][2], sacc[mi][ni][3]); \
      *(uint2*)(ST + (ni * 16 + r) * 136 + (2 * w + mi) * 16 + q * 4) = pk; } \
    lds_barrier(); }
  SEQ_LOAD_WQU(0, 0)
  SEQ_LOAD_AK(0, 0)
  __syncthreads();
  for (int c = 0; c < 32; c += 2) {
    SEQ_CHUNK(0, c)
    SEQ_CHUNK(1, c + 1)
  }
#undef SEQ_LOAD_WQU
#undef SEQ_LOAD_AK
#undef SEQ_CHUNK
#pragma unroll
  for (int mi = 0; mi < 2; ++mi)
#pragma unroll
    for (int ni = 0; ni < 2; ++ni)
#pragma unroll
      for (int j = 0; j < 4; ++j)
        p.p_gdn[((size_t)(b * 4 + h) * 128 + (2 * w + mi) * 16 + q * 4 + j) * 128 + sl * 32 + ni * 16 + r] = sacc[mi][ni][j];
}

__device__ void glu_tile(const Params& p, int idx, char* smem) {
  const int mt = idx >> 3, nt = idx & 7;
  f32x4 acc[4][4];
  gemm_std(p.ys5, 512, mt * 128, p.WgluT, 512, nt * 128, 8, acc, smem);
  EPI_COORDS
#pragma unroll
  for (int mi = 0; mi < 4; ++mi)
#pragma unroll
    for (int ni = 0; ni < 2; ++ni) {
      const int row = mt * 128 + wm * 64 + mi * 16 + r, col = nt * 64 + wn * 32 + ni * 16 + q * 4;
      float o[4];
#pragma unroll
      for (int j = 0; j < 4; ++j) o[j] = acc[mi][ni][j] * sigmoidf_(acc[mi][ni + 2][j]);
      uint2 pk; pk.x = pack2(o[0], o[1]); pk.y = pack2(o[2], o[3]);
      *(uint2*)(p.XN + (size_t)row * 1024 + col) = pk;
    }
}

template <int MASK>
DI void phase3(const Params& p, char* smem, int cofs) {
  constexpr int N_SEQ = 128, N_GLU = 129 * 8, N_GDEC = 512;
  for (;;) {
    int it = fetch_item(p.ctr + 3 + cofs);
    if (it >= N_SEQ + N_GLU + N_GDEC) break;
    if (it < N_SEQ) { if (MASK & 1) gdn_seq_item(p, it, smem); }
    else if (it < N_SEQ + N_GLU) { if (MASK & 2) glu_tile(p, it - N_SEQ, smem); }
    else { if (MASK & 2) gdn_decode_item(p, it - N_SEQ - N_GLU, smem); }
  }
}

__device__ void phase4(const Params& p) {
  const int lane = threadIdx.x & 63, w = threadIdx.x >> 6;
  for (int i = blockIdx.x * 256 + threadIdx.x; i < 128 * 1024 / 4; i += gridDim.x * 256)
    *(float4*)(p.out + (size_t)NTOK * 1024 + (size_t)i * 4) = *(const float4*)(p.x_sample + (size_t)i * 4);
  for (int it = blockIdx.x; it < NTOK / 4; it += gridDim.x) {
    const size_t row = (size_t)it * 4 + w;
    const float* op = p.ogdn + row * 512 + lane * 8;
    const float4 o0 = *(const float4*)op, o1 = *(const float4*)(op + 4);
    float ss = o0.x * o0.x + o0.y * o0.y + o0.z * o0.z + o0.w * o0.w + o1.x * o1.x + o1.y * o1.y + o1.z * o1.z + o1.w * o1.w;
    ss += __shfl_xor(ss, 1); ss += __shfl_xor(ss, 2); ss += __shfl_xor(ss, 4); ss += __shfl_xor(ss, 8);
    const float rs = rsqrtf(ss * (1.f / 128.f) + 1e-6f);
    const uint4 zr = *(const uint4*)(p.PROJ + row * NPROJ + 2048 + lane * 8);
    const float* gp = p.onorm_g + (lane & 15) * 8;
    const float4 g0 = *(const float4*)gp, g1 = *(const float4*)(gp + 4);
    uint4 pk;
    pk.x = pack2(o0.x * rs * g0.x * siluf_(bflo(zr.x)), o0.y * rs * g0.y * siluf_(bfhi(zr.x)));
    pk.y = pack2(o0.z * rs * g0.z * siluf_(bflo(zr.y)), o0.w * rs * g0.w * siluf_(bfhi(zr.y)));
    pk.z = pack2(o1.x * rs * g1.x * siluf_(bflo(zr.z)), o1.y * rs * g1.y * siluf_(bfhi(zr.z)));
    pk.w = pack2(o1.z * rs * g1.z * siluf_(bflo(zr.w)), o1.w * rs * g1.w * siluf_(bfhi(zr.w)));
    *(uint4*)(p.XN + row * 1024 + 512 + lane * 8) = pk;
  }
}

__device__ void phase5(const Params& p, char* smem, int vb) {
  for (int step = 0;; ++step) {
    int mt, nt; bool valid;
    if (!get_tile(vb, step, 128, 8, 8, mt, nt, valid)) break;
    if (!valid) continue;
    f32x4 acc[4][4];
    gemm_std(p.XN, 1024, mt * 128, p.WoutT, 1024, nt * 128, 16, acc, smem);
    EPI_COORDS
#pragma unroll
    for (int mi = 0; mi < 4; ++mi) {
      const int row = mt * 128 + wm * 64 + mi * 16 + r;
      const float* xr = xin_row(p, row);
      float4 xv[4];
#pragma unroll
      for (int ni = 0; ni < 4; ++ni) xv[ni] = *(const float4*)(xr + nt * 128 + wn * 64 + ni * 16 + q * 4);
#pragma unroll
      for (int ni = 0; ni < 4; ++ni) {
        float4 o; o.x = xv[ni].x + acc[mi][ni][0]; o.y = xv[ni].y + acc[mi][ni][1]; o.z = xv[ni].z + acc[mi][ni][2]; o.w = xv[ni].w + acc[mi][ni][3];
        *(float4*)(p.out + (size_t)row * 1024 + nt * 128 + wn * 64 + ni * 16 + q * 4) = o;
      }
    }
  }
  if (vb < 32) sample_splitk_task(p.out + (size_t)NTOK * 1024, 1024, p.XN, 1024, p.WoutT, 1024, vb & 7, vb >> 3, smem);
}

__device__ void phase_norm(const Params& p, bool final_) {
  const int lane = threadIdx.x & 63, w = threadIdx.x >> 6;
  const float* gw = final_ ? p.normf_g : p.norm2_g;
  float4 g[4];
#pragma unroll
  for (int i = 0; i < 4; ++i) g[i] = *(const float4*)(gw + i * 256 + lane * 4);
  for (int it = blockIdx.x; it < MROWS / 8; it += gridDim.x) {
    float4 v[2][4];
#pragma unroll
    for (int rr = 0; rr < 2; ++rr)
#pragma unroll
      for (int i = 0; i < 4; ++i) v[rr][i] = *(const float4*)(p.out + ((size_t)it * 8 + rr * 4 + w) * 1024 + i * 256 + lane * 4);
#pragma unroll
    for (int rr = 0; rr < 2; ++rr) {
      const size_t row = (size_t)it * 8 + rr * 4 + w;
      float* xr = p.out + row * 1024;
      float ss = 0.f;
#pragma unroll
      for (int i = 0; i < 4; ++i) ss += v[rr][i].x * v[rr][i].x + v[rr][i].y * v[rr][i].y + v[rr][i].z * v[rr][i].z + v[rr][i].w * v[rr][i].w;
      ss = wave_sum(ss);
      const float rstd = rsqrtf(ss * (1.f / 1024.f) + 1e-6f);
#pragma unroll
      for (int i = 0; i < 4; ++i) {
        float4 o; o.x = v[rr][i].x * rstd * g[i].x; o.y = v[rr][i].y * rstd * g[i].y; o.z = v[rr][i].z * rstd * g[i].z; o.w = v[rr][i].w * rstd * g[i].w;
        if (final_) *(float4*)(xr + i * 256 + lane * 4) = o;
        else { uint2 pk; pk.x = pack2(o.x, o.y); pk.y = pack2(o.z, o.w); *(uint2*)(p.XN + row * 1024 + i * 256 + lane * 4) = pk; }
      }
    }
  }
}

__device__ void phase7(const Params& p, char* smem, int vb) {
  constexpr int NT = 44, MT = 137;
  float* hl = (float*)smem;
  for (int step = 0;; ++step) {
    int mt, nt;
    if (!get_tile_strip(vb, step, MT, NT, 4, mt, nt)) break;
    const bool samp = mt == 136;
    const int bb = mt / 17, ii = mt % 17;
    f32x4 acc[4][4];
    {
      const int t = threadIdx.x;
      unsigned amask = 0;
      long arow0;
      if (samp) { arow0 = NTOK + (t >> 3); amask = 0xfu; }
      else {
        arow0 = (long)bb * 2048 + 126 * ii - 2 + (t >> 3);
#pragma unroll
        for (int i = 0; i < 4; ++i) { const int tok = 126 * ii - 2 + (t >> 3) + 32 * i; if (tok >= 0 && tok < 2048) amask |= 1u << i; }
      }
      const bf16_t* a0 = p.XN + arow0 * 1024 + (t & 7) * 8;
      const bf16_t* b0 = p.WupT + (size_t)(nt * 128 + (t >> 3)) * 1024 + (t & 7) * 8;
      gemm_main<true>(a0, (size_t)32 * 1024, amask, b0, (size_t)32 * 1024, 16, acc, smem);
    }
    EPI_COORDS
    __syncthreads();
#pragma unroll
    for (int mi = 0; mi < 4; ++mi)
#pragma unroll
      for (int ni = 0; ni < 4; ++ni)
#pragma unroll
        for (int j = 0; j < 4; ++j) hl[(wm * 64 + mi * 16 + r) * 132 + wn * 64 + ni * 16 + q * 4 + j] = acc[mi][ni][j];
    __syncthreads();
    {
      const int jp = t & 31, rbase = (t >> 5) * 16;
      const int hsel = jp >> 4, lc = hsel * 64 + 2 * (jp & 15);
      const int colp = nt * 64 + hsel * 32 + 2 * (jp & 15);
      const float2 wg0 = *(const float2*)(p.ffn_conv_w + colp), wg1 = *(const float2*)(p.ffn_conv_w + 5632 + colp), wg2 = *(const float2*)(p.ffn_conv_w + 2 * 5632 + colp);
      const float2 wu0 = *(const float2*)(p.ffn_conv_w + 2816 + colp), wu1 = *(const float2*)(p.ffn_conv_w + 5632 + 2816 + colp), wu2 = *(const float2*)(p.ffn_conv_w + 2 * 5632 + 2816 + colp);
      if (samp) {
#pragma unroll 2
        for (int rr = 0; rr < 16; ++rr) {
          const int sidx = rbase + rr;
          const float* sb = p.st_ffn_conv + (size_t)sidx * 2 * 5632;
          const float2 g0 = *(const float2*)(sb + colp), g1 = *(const float2*)(sb + 5632 + colp), u0 = *(const float2*)(sb + 2816 + colp), u1 = *(const float2*)(sb + 5632 + 2816 + colp);
          const float2 hg = *(const float2*)(hl + sidx * 132 + lc), hu = *(const float2*)(hl + sidx * 132 + lc + 32);
          const float ga = g0.x * wg0.x + g1.x * wg1.x + hg.x * wg2.x, gb = g0.y * wg0.y + g1.y * wg1.y + hg.y * wg2.y;
          const float ua = u0.x * wu0.x + u1.x * wu1.x + hu.x * wu2.x, ub = u0.y * wu0.y + u1.y * wu1.y + hu.y * wu2.y;
          *(unsigned*)(p.ACT + (size_t)(NTOK + sidx) * 2816 + colp) = pack2(siluf_(ga) * ua, siluf_(gb) * ub);
          float* ob = p.s_ffn_conv + (size_t)sidx * 2 * 5632;
          *(float2*)(ob + colp) = g1; *(float2*)(ob + 2816 + colp) = u1; *(float2*)(ob + 5632 + colp) = hg; *(float2*)(ob + 5632 + 2816 + colp) = hu;
        }
      } else {
        float2 ga = make_float2(0.f, 0.f), gb = ga, ua = ga, ub = ga;
        if (rbase >= 2) {
          ga = *(const float2*)(hl + (rbase - 2) * 132 + lc); gb = *(const float2*)(hl + (rbase - 1) * 132 + lc);
          ua = *(const float2*)(hl + (rbase - 2) * 132 + lc + 32); ub = *(const float2*)(hl + (rbase - 1) * 132 + lc + 32);
        }
#pragma unroll 4
        for (int rr = 0; rr < 16; ++rr) {
          const int rowt = rbase + rr;
          const int tok = 126 * ii - 2 + rowt;
          float2 gc = *(const float2*)(hl + rowt * 132 + lc), uc = *(const float2*)(hl + rowt * 132 + lc + 32);
          if (tok < 0) { gc = make_float2(0.f, 0.f); uc = gc; }
          if (rowt >= 2 && tok < 2048) {
            const float g0 = ga.x * wg0.x + gb.x * wg1.x + gc.x * wg2.x, g1 = ga.y * wg0.y + gb.y * wg1.y + gc.y * wg2.y;
            const float u0 = ua.x * wu0.x + ub.x * wu1.x + uc.x * wu2.x, u1 = ua.y * wu0.y + ub.y * wu1.y + uc.y * wu2.y;
            *(unsigned*)(p.ACT + ((size_t)bb * 2048 + tok) * 2816 + colp) = pack2(siluf_(g0) * u0, siluf_(g1) * u1);
            if (tok >= 2046) {
              float* ob = p.p_ffn_conv + (size_t)(bb * 2 + (tok - 2046)) * 5632;
              *(float2*)(ob + colp) = gc; *(float2*)(ob + 2816 + colp) = uc;
            }
          }
          ga = gb; gb = gc; ua = ub; ub = uc;
        }
      }
    }
  }
}

__device__ void phase8(const Params& p, char* smem, int vb) {
  for (int step = 0;; ++step) {
    int mt, nt; bool valid;
    if (!get_tile(vb, step, 128, 8, 8, mt, nt, valid)) break;
    if (!valid) continue;
    f32x4 acc[4][4];
    gemm_std(p.ACT, 2816, mt * 128, p.WdnT, 2816, nt * 128, 44, acc, smem);
    EPI_COORDS
#pragma unroll
    for (int mi = 0; mi < 4; ++mi) {
      float* orow = p.out + (size_t)(mt * 128 + wm * 64 + mi * 16 + r) * 1024 + nt * 128 + wn * 64 + q * 4;
      float4 xv[4];
#pragma unroll
      for (int ni = 0; ni < 4; ++ni) xv[ni] = *(const float4*)(orow + ni * 16);
#pragma unroll
      for (int ni = 0; ni < 4; ++ni) {
        float4 o; o.x = xv[ni].x + acc[mi][ni][0]; o.y = xv[ni].y + acc[mi][ni][1]; o.z = xv[ni].z + acc[mi][ni][2]; o.w = xv[ni].w + acc[mi][ni][3];
        *(float4*)(orow + ni * 16) = o;
      }
    }
  }
  if (vb < 88) sample_splitk_task(p.out + (size_t)NTOK * 1024, 1024, p.ACT, 2816, p.WdnT, 2816, vb & 7, vb >> 3, smem);
}

template <int PH>
DI void run_phase(const Params& p, char* smem, int vb, int cofs = 0) {
  if (PH == 0) phase0(p, smem);
  else if (PH == 1) { if (cofs) phase1<REP_MODE + 10 * 0>(p, smem, vb); else phase1<0>(p, smem, vb); }
  else if (PH == 2) { if (cofs) phase2<REP_MASK>(p, smem, cofs); else phase2<15>(p, smem, 0); }
  else if (PH == 3) { if (cofs) phase3<(REP_MASK & 3)>(p, smem, cofs); else phase3<3>(p, smem, 0); }
  else if (PH == 4) phase4(p);
  else if (PH == 5) phase5(p, smem, vb);
  else if (PH == 6) phase_norm(p, false);
  else if (PH == 7) phase7(p, smem, vb);
  else if (PH == 8) phase8(p, smem, vb);
  else phase_norm(p, true);
}

template <int PH>
__global__ void __launch_bounds__(256, 2) phase_kernel(Params p) {
  __shared__ __attribute__((aligned(16))) char smem[SMEM_BYTES];
  run_phase<PH>(p, smem, blockIdx.x);
}


#define XB_TMO      128
#define XB_XCNT(j)  (256  + 64 * (j))
#define XB_XSUB(j)  (1280 + 64 * (j))
#define XB_XGEN(j)  (2304 + 64 * (j))
#define XB_TOP      3328
#define XB_TOPGEN   3392
#define XCD_BAR_WORDS 3456
#define XB_SPIN_CAP (1u << 18)
#define LAS __attribute__((address_space(3)))
DI unsigned xb_ld(unsigned* p) { return __hip_atomic_load(p, __ATOMIC_RELAXED, __HIP_MEMORY_SCOPE_AGENT); }
DI unsigned xb_add(unsigned* p, unsigned v) { return __hip_atomic_fetch_add(p, v, __ATOMIC_RELAXED, __HIP_MEMORY_SCOPE_AGENT); }
DI unsigned xb_xcc_id() { return (unsigned)__builtin_amdgcn_s_getreg((3 << 11) | 20) & 0xFu; }
#define XB_SPIN(cond, bar) do { unsigned _sp = 0; while (cond) { __builtin_amdgcn_s_sleep(1); \
    if ((++_sp & 255u) == 0u) { if (xb_ld(&(bar)[XB_TMO])) break; if (_sp > XB_SPIN_CAP) { atomicAdd(&(bar)[XB_TMO], 1u); break; } } } } while (0)
struct XcdBarrier { unsigned* bar; unsigned x; volatile LAS unsigned* st; };
DI XcdBarrier xcd_barrier_post(unsigned* bar, volatile LAS unsigned* st) {
  XcdBarrier b; b.bar = bar; b.x = xb_xcc_id(); b.st = st;
  if (threadIdx.x == 0) (void)xb_add(&bar[XB_XCNT(b.x)], 1u);
  return b;
}
DI void xcd_barrier_complete(unsigned* bar, unsigned x, unsigned& nloc, unsigned& nx) {
  const unsigned G = gridDim.x * gridDim.y * gridDim.z;
  unsigned sum, cnt, mine, sp = 0u;
  for (;;) {
    sum = 0u; cnt = 0u; mine = 0u;
#pragma unroll
    for (unsigned j = 0; j < 16; ++j) { const unsigned c = xb_ld(&bar[XB_XCNT(j)]); sum += c; cnt += (c > 0u) ? 1u : 0u; mine = (j == x) ? c : mine; }
    if (sum == G) break;
    __builtin_amdgcn_s_sleep(1);
    if ((++sp & 255u) == 0u) { if (xb_ld(&bar[XB_TMO])) break; if (sp > XB_SPIN_CAP) { atomicAdd(&bar[XB_TMO], 1u); break; } }
  }
  nloc = mine > 0u ? mine : 1u; nx = cnt > 0u ? cnt : 1u;
}
DI void xcd_barrier(const XcdBarrier& b) {
  asm volatile("s_waitcnt vmcnt(0)" ::: "memory");
  __syncthreads();
  if (threadIdx.x == 0) {
    unsigned* bar = b.bar;
    __builtin_amdgcn_s_waitcnt(0);
    unsigned nloc = b.st[0], nx = b.st[1];
    if (nloc == 0u) { xcd_barrier_complete(bar, b.x, nloc, nx); b.st[0] = nloc; b.st[1] = nx; }
    const unsigned old = xb_add(&bar[XB_XSUB(b.x)], 1u);
    const unsigned gen = old / nloc;
    if (old + 1u == (gen + 1u) * nloc) {
      __builtin_amdgcn_fence(__ATOMIC_RELEASE, "agent");
      asm volatile("s_waitcnt vmcnt(0)" ::: "memory");
      const unsigned og = xb_add(&bar[XB_TOP], 1u);
      const unsigned tg = og / nx;
      if (og + 1u == (tg + 1u) * nx) xb_add(&bar[XB_TOPGEN], 1u);
      else XB_SPIN(xb_ld(&bar[XB_TOPGEN]) == tg, bar);
      __builtin_amdgcn_fence(__ATOMIC_ACQUIRE, "agent");
      xb_add(&bar[XB_XGEN(b.x)], 1u);
      asm volatile("s_waitcnt vmcnt(0)" ::: "memory");
    } else {
      XB_SPIN(xb_ld(&bar[XB_XGEN(b.x)]) == gen, bar);
      __builtin_amdgcn_fence(__ATOMIC_ACQUIRE, "agent");
      asm volatile("s_waitcnt vmcnt(0)" ::: "memory");
    }
  }
  __syncthreads();
}

__shared__ int s_vb;
__shared__ uint4 xb_words;
__global__ void __launch_bounds__(256, 2) fwd_megakernel(Params p) {
  __shared__ __attribute__((aligned(16))) char smem[SMEM_BYTES];
  if (p.bar == nullptr) cg::this_grid().sync();
  if (threadIdx.x == 0) xb_words = make_uint4(0u, 0u, 0u, 0u);
  __syncthreads();
  XcdBarrier xb = xcd_barrier_post(p.bar, (volatile LAS unsigned*)&xb_words);
  int xloc = 0;
  if (threadIdx.x == 0) xloc = atomicAdd(p.ctr + 16 + (int)(xb.x & 7u), 1);
  run_phase<0>(p, smem, blockIdx.x); xcd_barrier(xb);
#if defined(REP_PHASE) && REP_PHASE == 0
  run_phase<0>(p, smem, blockIdx.x); xcd_barrier(xb);
#endif
  if (threadIdx.x == 0) {
    bool even = (gridDim.x & 7) == 0;
    for (int i = 0; i < 8; ++i) even = even && (__hip_atomic_load(p.ctr + 16 + i, __ATOMIC_RELAXED, __HIP_MEMORY_SCOPE_AGENT) == (int)(gridDim.x >> 3));
    s_vb = even ? xloc * 8 + (int)(xb.x & 7u) : (int)blockIdx.x;
  }
  __syncthreads();
  const int vb = s_vb;
  run_phase<1>(p, smem, vb); xcd_barrier(xb);
#if defined(REP_PHASE) && REP_PHASE == 1
  run_phase<1>(p, smem, vb, 8); xcd_barrier(xb);
#endif
  run_phase<2>(p, smem, vb); xcd_barrier(xb);
#if defined(REP_PHASE) && REP_PHASE == 2
  run_phase<2>(p, smem, vb, 8); xcd_barrier(xb);
#endif
  run_phase<3>(p, smem, vb); xcd_barrier(xb);
#if defined(REP_PHASE) && REP_PHASE == 3
  run_phase<3>(p, smem, vb, 8); xcd_barrier(xb);
#endif
  run_phase<4>(p, smem, vb); xcd_barrier(xb);
#if defined(REP_PHASE) && REP_PHASE == 4
  run_phase<4>(p, smem, vb, 8); xcd_barrier(xb);
#endif
  run_phase<5>(p, smem, vb); xcd_barrier(xb);
#if defined(REP_PHASE) && REP_PHASE == 5
  run_phase<5>(p, smem, vb, 8); xcd_barrier(xb);
#endif
  run_phase<6>(p, smem, vb); xcd_barrier(xb);
#if defined(REP_PHASE) && REP_PHASE == 6
  run_phase<6>(p, smem, vb, 8); xcd_barrier(xb);
#endif
  run_phase<7>(p, smem, vb); xcd_barrier(xb);
#if defined(REP_PHASE) && REP_PHASE == 7
  run_phase<7>(p, smem, vb, 8); xcd_barrier(xb);
#endif
  run_phase<8>(p, smem, vb); xcd_barrier(xb);
#if defined(REP_PHASE) && REP_PHASE == 8
  run_phase<8>(p, smem, vb, 8); xcd_barrier(xb);
#endif
  run_phase<9>(p, smem, vb);
}

extern "C" void kernel_launch(void* const* d_in, const int* in_sizes, int n_in, void* d_out, int out_size, void* d_ws, size_t ws_size, hipStream_t stream) {
  static int grid_blocks = 0;
  if (!grid_blocks) {
    int dev = 0, cus = 0, per_cu = 0;
    (void)hipGetDevice(&dev);
    (void)hipDeviceGetAttribute(&cus, hipDeviceAttributeMultiprocessorCount, dev);
    (void)hipOccupancyMaxActiveBlocksPerMultiprocessor(&per_cu, fwd_megakernel, 256, 0);
    if (per_cu < 1) per_cu = 1;
    if (per_cu > 2) per_cu = 2;
    grid_blocks = cus * per_cu;
  }
  Params p{};
  const float* const* in = (const float* const*)d_in;
  p.x_prompt = in[0]; p.x_sample = in[1]; p.st_s5_re = in[2]; p.st_s5_im = in[3]; p.st_gdn = in[4]; p.st_gdn_conv = in[5]; p.st_ffn_conv = in[6];
  p.norm1_g = in[7]; p.w_in = in[8]; p.a_re = in[9]; p.a_im = in[10]; p.log_dt = in[11]; p.b_re = in[12]; p.b_im = in[13]; p.c_re = in[14]; p.c_im = in[15];
  p.s5_d = in[16]; p.w_glu = in[17]; p.gdn_conv_w = in[18]; p.a_log = in[19]; p.dt_bias = in[20]; p.onorm_g = in[21]; p.w_out = in[22]; p.norm2_g = in[23];
  p.w_up = in[24]; p.ffn_conv_w = in[25]; p.w_down = in[26]; p.normf_g = in[27];
  float* o = (float*)d_out;
  p.out = o;
  size_t off = (size_t)MROWS * 1024;
  p.p_s5_re = o + off; off += 8 * 32 * 64;
  p.p_s5_im = o + off; off += 8 * 32 * 64;
  p.p_gdn = o + off; off += (size_t)8 * 4 * 128 * 128;
  p.p_gdn_conv = o + off; off += 8 * 3 * 1536;
  p.p_ffn_conv = o + off; off += 8 * 2 * 5632;
  p.s_s5_re = o + off; off += 128 * 32 * 64;
  p.s_s5_im = o + off; off += 128 * 32 * 64;
  p.s_gdn = o + off; off += (size_t)128 * 4 * 128 * 128;
  p.s_gdn_conv = o + off; off += 128 * 3 * 1536;
  p.s_ffn_conv = o + off; off += 128 * 2 * 5632;
  p.ogdn = o;
  p.ys5 = (bf16_t*)(o + (size_t)NTOK * 512);
  char* ws = (char*)d_ws;
  size_t wo = 0;
  auto take = [&](size_t bytes) { char* r = ws + wo; wo += (bytes + 255) & ~(size_t)255; return r; };
  p.ctr = (int*)take(256);
  p.bar = (unsigned*)take(XCD_BAR_WORDS * 4);
  p.ba = (float*)take((size_t)MROWS * 8 * 4);
  p.glast = (float*)take(1024 * 4);
  p.sproj = (float*)take((size_t)128 * NPROJ * 4);
  p.WinT = (bf16_t*)take((size_t)2560 * 1024 * 2);
  p.WgluT = (bf16_t*)take((size_t)1024 * 512 * 2);
  p.WoutT = (bf16_t*)take((size_t)1024 * 1024 * 2);
  p.WupT = (bf16_t*)take((size_t)5632 * 1024 * 2);
  p.WdnT = (bf16_t*)take((size_t)1024 * 2816 * 2);
  p.XN = (bf16_t*)take((size_t)MROWS * 1024 * 2);
  p.PROJ = (bf16_t*)take((size_t)MROWS * NPROJ * 2);
  p.ACT = p.PROJ;
  p.GDNI = (bf16_t*)take((size_t)1024 * 36864 * 2);
  if (wo > ws_size) { fprintf(stderr, "workspace too small: need %zu have %zu\n", wo, ws_size); return; }
  (void)hipMemsetAsync(p.ctr, 0, 256 + ((XCD_BAR_WORDS * 4 + 255) & ~255), stream);
#if MK_MULTI
  phase_kernel<0><<<grid_blocks, 256, 0, stream>>>(p);
  phase_kernel<1><<<grid_blocks, 256, 0, stream>>>(p);
  phase_kernel<2><<<grid_blocks, 256, 0, stream>>>(p);
  phase_kernel<3><<<grid_blocks, 256, 0, stream>>>(p);
  phase_kernel<4><<<grid_blocks, 256, 0, stream>>>(p);
  phase_kernel<5><<<grid_blocks, 256, 0, stream>>>(p);
  phase_kernel<6><<<grid_blocks, 256, 0, stream>>>(p);
  phase_kernel<7><<<grid_blocks, 256, 0, stream>>>(p);
  phase_kernel<8><<<grid_blocks, 256, 0, stream>>>(p);
  phase_kernel<9><<<grid_blocks, 256, 0, stream>>>(p);
#else
  void* args[] = {&p};
  hipError_t e = hipLaunchCooperativeKernel((void*)fwd_megakernel, dim3(grid_blocks), dim3(256), args, 0, stream);
  if (e != hipSuccess) fprintf(stderr, "cooperative launch failed: %s (grid %d)\n", hipGetErrorString(e), grid_blocks);
#endif
}
```

```cpp
#include <hip/hip_runtime.h>
#include <hip/hip_cooperative_groups.h>
#include <cstdio>
namespace cg = cooperative_groups;

#ifndef MK_MULTI
#define MK_MULTI 0
#endif

typedef unsigned short bf16_t;
using bf16x8 = __attribute__((ext_vector_type(8))) short;
using f32x4 = __attribute__((ext_vector_type(4))) float;
using u32x4 = __attribute__((ext_vector_type(4))) unsigned;

#define DI __device__ __forceinline__

typedef __bf16 bf16x2_t __attribute__((ext_vector_type(2)));
typedef float f32x2_t __attribute__((ext_vector_type(2)));
DI bf16_t f2bf(float x) { __bf16 h = (__bf16)x; return __builtin_bit_cast(bf16_t, h); }
DI float bf2f(bf16_t b) { return __uint_as_float(((unsigned)b) << 16); }
DI unsigned pack2(float a, float b) { f32x2_t v = {a, b}; bf16x2_t r = __builtin_convertvector(v, bf16x2_t); return __builtin_bit_cast(unsigned, r); }
DI float bflo(unsigned u) { return __uint_as_float(u << 16); }
DI float bfhi(unsigned u) { return __uint_as_float(u & 0xffff0000u); }
DI float sigmoidf_(float x) { return 1.f / (1.f + __expf(-x)); }
DI float siluf_(float x) { return x / (1.f + __expf(-x)); }
DI float geluf_(float x) { float u = 0.7978845608028654f * (x + 0.044715f * x * x * x); float th = 1.f - 2.f / (1.f + __expf(2.f * u)); return 0.5f * x * (1.f + th); }
DI float wave_sum(float v) { for (int o = 32; o > 0; o >>= 1) v += __shfl_xor(v, o); return v; }
DI f32x4 mfma16(bf16x8 a, bf16x8 b, f32x4 c) { return __builtin_amdgcn_mfma_f32_16x16x32_bf16(a, b, c, 0, 0, 0); }

constexpr int NTOK = 16384;
constexpr int MROWS = 16512;
constexpr int NPROJ = 2560;
constexpr int SMEM_BYTES = 67584;

struct Params {
  const float *x_prompt, *x_sample, *st_s5_re, *st_s5_im, *st_gdn, *st_gdn_conv, *st_ffn_conv;
  const float *norm1_g, *w_in, *a_re, *a_im, *log_dt, *b_re, *b_im, *c_re, *c_im, *s5_d, *w_glu;
  const float *gdn_conv_w, *a_log, *dt_bias, *onorm_g, *w_out, *norm2_g, *w_up, *ffn_conv_w, *w_down, *normf_g;
  float *out;
  float *p_s5_re, *p_s5_im, *p_gdn, *p_gdn_conv, *p_ffn_conv, *s_s5_re, *s_s5_im, *s_gdn, *s_gdn_conv, *s_ffn_conv;
  float *ogdn;
  bf16_t *ys5;
  int *ctr; unsigned *bar; float *ba; float *glast; float *sproj;
  bf16_t *WinT, *WgluT, *WoutT, *WupT, *WdnT, *XN, *PROJ, *GDNI, *ACT;
};

DI const float* xin_row(const Params& p, int row) {
  return row < NTOK ? p.x_prompt + (size_t)row * 1024 : p.x_sample + (size_t)(row - NTOK) * 1024;
}

__shared__ int s_item;
DI int fetch_item(int* ctr) {
  __syncthreads();
  if (threadIdx.x == 0) s_item = atomicAdd(ctr, 1);
  __syncthreads();
  return s_item;
}

DI void lds_barrier() { asm volatile("s_waitcnt lgkmcnt(0)\n\ts_barrier" ::: "memory"); }

DI float block_sum(float v, float* red) {
  v = wave_sum(v);
  __syncthreads();
  if ((threadIdx.x & 63) == 0) red[threadIdx.x >> 6] = v;
  __syncthreads();
  return red[0] + red[1] + red[2] + red[3];
}

DI void transpose_item(const float* src, int ldsrc, int srccol0, int k0, bf16_t* dst, int lddst, int r0, float* tl) {
  const int t = threadIdx.x;
  float v[4][8];
  { const int jj = t & 31, kk = t >> 5;
#pragma unroll
    for (int kb = 0; kb < 4; ++kb)
#pragma unroll
      for (int i = 0; i < 8; ++i) v[kb][i] = src[(size_t)(k0 + kb * 64 + kk + 8 * i) * ldsrc + srccol0 + jj]; }
#pragma unroll
  for (int kb = 0; kb < 4; ++kb) {
    { const int jj = t & 31, kk = t >> 5;
#pragma unroll
      for (int i = 0; i < 8; ++i) tl[(kk + 8 * i) * 33 + jj] = v[kb][i]; }
    __syncthreads();
    { const int kk = t & 63, jj = t >> 6;
#pragma unroll
      for (int i = 0; i < 8; ++i) dst[(size_t)(r0 + jj + 4 * i) * lddst + k0 + kb * 64 + kk] = f2bf(tl[kk * 33 + jj + 4 * i]); }
    __syncthreads();
  }
}

DI int perm_col(int r0, int halfoff) {
  const int tt = r0 >> 7, rr = r0 & 127, wn = rr >> 6, half = (rr >> 5) & 1;
  return half * halfoff + tt * 64 + wn * 32;
}

__device__ void phase0(const Params& p, char* smem) {
  float* wt = (float*)smem;
  float* tl = (float*)(smem + 32768);
  for (int i = threadIdx.x; i < 8192; i += 256) { const int k = i >> 3, j = i & 7; wt[j * 1024 + k] = p.w_in[(size_t)k * 2568 + 2560 + j]; }
  __syncthreads();
  for (int i = blockIdx.x * 256 + threadIdx.x; i < 128 * NPROJ / 4; i += gridDim.x * 256) *(float4*)(p.sproj + (size_t)i * 4) = make_float4(0.f, 0.f, 0.f, 0.f);
  constexpr int NT_IN = 320, NT_GLU = 64, NT_OUT = 128, NT_UP = 704, NT_DN = 352;
  constexpr int nT = NT_IN + NT_GLU + NT_OUT + NT_UP + NT_DN;
  constexpr int nRow = MROWS / 8;
  for (int it = blockIdx.x; it < nT + nRow; it += gridDim.x) {
    if (it < nT) {
      int i = it;
      if (i < NT_IN) { const int r0 = (i >> 2) * 32, k0 = (i & 3) * 256; transpose_item(p.w_in, 2568, r0, k0, p.WinT, 1024, r0, tl); continue; }
      i -= NT_IN;
      if (i < NT_GLU) { const int r0 = (i >> 1) * 32, k0 = (i & 1) * 256; transpose_item(p.w_glu, 1024, perm_col(r0, 512), k0, p.WgluT, 512, r0, tl); continue; }
      i -= NT_GLU;
      if (i < NT_OUT) { const int r0 = (i >> 2) * 32, k0 = (i & 3) * 256; transpose_item(p.w_out, 1024, r0, k0, p.WoutT, 1024, r0, tl); continue; }
      i -= NT_OUT;
      if (i < NT_UP) { const int r0 = (i >> 2) * 32, k0 = (i & 3) * 256; transpose_item(p.w_up, 5632, perm_col(r0, 2816), k0, p.WupT, 1024, r0, tl); continue; }
      i -= NT_UP;
      { const int r0 = (i / 11) * 32, k0 = (i % 11) * 256; transpose_item(p.w_down, 1024, r0, k0, p.WdnT, 2816, r0, tl); }
    } else {
      const int lane = threadIdx.x & 63, w = threadIdx.x >> 6;
      float4 v2[2][4];
#pragma unroll
      for (int rr = 0; rr < 2; ++rr) {
        const float* xr = xin_row(p, (it - nT) * 8 + rr * 4 + w);
#pragma unroll
        for (int i = 0; i < 4; ++i) v2[rr][i] = *(const float4*)(xr + i * 256 + lane * 4);
      }
#pragma unroll
      for (int rr = 0; rr < 2; ++rr) {
        const int row = (it - nT) * 8 + rr * 4 + w;
        float4 v[4]; float ss = 0.f;
#pragma unroll
        for (int i = 0; i < 4; ++i) { v[i] = v2[rr][i]; ss += v[i].x * v[i].x + v[i].y * v[i].y + v[i].z * v[i].z + v[i].w * v[i].w; }
        ss = wave_sum(ss);
        const float rstd = rsqrtf(ss * (1.f / 1024.f) + 1e-6f);
        float acc[8];
#pragma unroll
        for (int j = 0; j < 8; ++j) acc[j] = 0.f;
#pragma unroll
        for (int i = 0; i < 4; ++i) {
          const float4 g = *(const float4*)(p.norm1_g + i * 256 + lane * 4);
          v[i].x *= rstd * g.x; v[i].y *= rstd * g.y; v[i].z *= rstd * g.z; v[i].w *= rstd * g.w;
          uint2 pk; pk.x = pack2(v[i].x, v[i].y); pk.y = pack2(v[i].z, v[i].w);
          *(uint2*)(p.XN + (size_t)row * 1024 + i * 256 + lane * 4) = pk;
#pragma unroll
          for (int j = 0; j < 8; ++j) { const float4 wv = *(const float4*)(wt + j * 1024 + i * 256 + lane * 4); acc[j] += v[i].x * wv.x + v[i].y * wv.y + v[i].z * wv.z + v[i].w * wv.w; }
        }
#pragma unroll
        for (int j = 0; j < 8; ++j) acc[j] = wave_sum(acc[j]);
        if (lane == 0) {
          *(float4*)(p.ba + (size_t)row * 8) = make_float4(acc[0], acc[1], acc[2], acc[3]);
          *(float4*)(p.ba + (size_t)row * 8 + 4) = make_float4(acc[4], acc[5], acc[6], acc[7]);
        }
      }
    }
  }
}

template <bool NULLCHK, int PMODE = 0>
DI void gemm_main(const bf16_t* a0, size_t astr, unsigned amask, const bf16_t* b0, size_t bstr, int nk, f32x4 (&acc)[4][4], char* smem) {
  char* As = smem;
  char* Bs = smem + 16384;
  const int t = threadIdx.x, lane = t & 63, w = t >> 6, wm = w >> 1, wn = w & 1, r = lane & 15, q = lane >> 4;
  const u32x4 z4 = u32x4{0u, 0u, 0u, 0u};
  u32x4 ra0[4], rb0[4];
  const int soff = (t >> 3) * 128 + (((t & 7) ^ ((t >> 3) & 7)) * 16);
  const int aoff = (wm * 64 + r) * 128, boff = (wn * 64 + r) * 128;
  const int sw0 = ((q) ^ (r & 7)) * 16, sw1 = ((4 + q) ^ (r & 7)) * 16;
#define G_LOAD(RA, RB, KT) _Pragma("unroll") for (int i = 0; i < 4; ++i) { \
    RA[i] = (!NULLCHK || ((amask >> i) & 1u)) ? *(const u32x4*)(a0 + i * astr + (KT) * 64) : z4; \
    RB[i] = *(const u32x4*)(b0 + i * bstr + (KT) * 64); }
#define G_STORE(RA, RB) _Pragma("unroll") for (int i = 0; i < 4; ++i) { \
    *(u32x4*)(As + soff + i * 4096) = RA[i]; \
    *(u32x4*)(Bs + soff + i * 4096) = RB[i]; }
#define G_COMPUTE() _Pragma("unroll") for (int ks = 0; ks < 2; ++ks) { \
    bf16x8 af[4], bfr[4]; \
    _Pragma("unroll") for (int mi = 0; mi < 4; ++mi) af[mi] = *(const bf16x8*)(As + aoff + mi * 2048 + (ks ? sw1 : sw0)); \
    _Pragma("unroll") for (int ni = 0; ni < 4; ++ni) bfr[ni] = *(const bf16x8*)(Bs + boff + ni * 2048 + (ks ? sw1 : sw0)); \
    __builtin_amdgcn_s_setprio(1); \
    _Pragma("unroll") for (int mi = 0; mi < 4; ++mi) _Pragma("unroll") for (int ni = 0; ni < 4; ++ni) acc[mi][ni] = mfma16(bfr[ni], af[mi], acc[mi][ni]); \
    __builtin_amdgcn_s_setprio(0); }
  G_LOAD(ra0, rb0, 0)
#pragma unroll
  for (int mi = 0; mi < 4; ++mi)
#pragma unroll
    for (int ni = 0; ni < 4; ++ni) acc[mi][ni] = f32x4{0.f, 0.f, 0.f, 0.f};
  for (int kt = 0; kt < nk; ++kt) {
    if (kt == 0) __syncthreads(); else lds_barrier();
    G_STORE(ra0, rb0)
    lds_barrier();
    if (PMODE != 1 && kt + 1 < nk) { G_LOAD(ra0, rb0, kt + 1) }
    __builtin_amdgcn_sched_barrier(0);
    G_COMPUTE()
  }
#undef G_LOAD
#undef G_STORE
#undef G_COMPUTE
}

template <int PMODE = 0>
DI void gemm_std(const bf16_t* A, int lda, int m0, const bf16_t* Bt, int ldb, int n0, int nk, f32x4 (&acc)[4][4], char* smem) {
  const int t = threadIdx.x;
  const bf16_t* a0 = A + (size_t)(m0 + (t >> 3)) * lda + (t & 7) * 8;
  const bf16_t* b0 = Bt + (size_t)(n0 + (t >> 3)) * ldb + (t & 7) * 8;
  gemm_main<false, PMODE>(a0, (size_t)32 * lda, 0xfu, b0, (size_t)32 * ldb, nk, acc, smem);
}

DI bool get_tile(int vb, int step, int MT, int NT, int GW, int& mt, int& nt, bool& valid) {
  const int G = gridDim.x;
  if ((G & 7) == 0 && ((G >> 3) % GW) == 0) {
    const int xcd = vb & 7, local = vb >> 3, GH = (G >> 3) / GW;
    const int NGN = (NT + GW - 1) / GW, NGM = (MT + GH - 1) / GH;
    const int g = step * 8 + xcd;
    if (g >= NGN * NGM) return false;
    mt = (g / NGN) * GH + local / GW; nt = (g % NGN) * GW + local % GW;
    valid = mt < MT && nt < NT;
    return true;
  }
  const int idx = vb + step * G;
  if (idx >= MT * NT) return false;
  mt = idx / NT; nt = idx % NT; valid = true;
  return true;
}

DI bool get_tile_strip(int vb, int step, int MT, int NT, int GW, int& mt, int& nt) {
  const int G = gridDim.x, T = MT * NT;
  int idx;
  if ((G & 7) == 0) {
    const int xcd = vb & 7, local = vb >> 3, lpx = G >> 3;
    const int start = (int)(((long)T * xcd) >> 3), end = (int)(((long)T * (xcd + 1)) >> 3);
    idx = start + local + lpx * step;
    if (idx >= end) return false;
  } else {
    idx = vb + step * G;
    if (idx >= T) return false;
  }
  const int strip = idx / (MT * GW), rem = idx % (MT * GW);
  mt = rem / GW; nt = strip * GW + rem % GW;
  return true;
}

#define EPI_COORDS const int t = threadIdx.x, lane = t & 63, w = t >> 6, wm = w >> 1, wn = w & 1, r = lane & 15, q = lane >> 4; (void)wm; (void)wn; (void)r; (void)q;

DI void sample_splitk_task(float* obase, int ldo, const bf16_t* A, int lda, const bf16_t* Bt, int ldb, int nt, int ks, char* smem) {
  f32x4 acc[4][4];
  gemm_std(A + (size_t)ks * 256, lda, NTOK, Bt + (size_t)ks * 256, ldb, nt * 128, 4, acc, smem);
  EPI_COORDS
#pragma unroll
  for (int mi = 0; mi < 4; ++mi)
#pragma unroll
    for (int ni = 0; ni < 4; ++ni) {
      float* o = obase + (size_t)(wm * 64 + mi * 16 + r) * ldo + nt * 128 + wn * 64 + ni * 16 + q * 4;
#pragma unroll
      for (int j = 0; j < 4; ++j) unsafeAtomicAdd(o + j, acc[mi][ni][j]);
    }
}

#ifndef REP_MODE
#define REP_MODE 0
#endif
template <int PMODE>
DI void phase1(const Params& p, char* smem, int vb) {
  constexpr int NT = 20, MT = 128;
  if (PMODE == 0 && vb < 80) sample_splitk_task(p.sproj, NPROJ, p.XN, 1024, p.WinT, 1024, vb % 20, vb / 20, smem);
  for (int step = 0;; ++step) {
    int mt, nt;
    if (!get_tile_strip(vb, step, MT, NT, 4, mt, nt)) break;
    f32x4 acc[4][4];
    if (PMODE == 2) gemm_std<0>(p.XN, 1024, 0, p.WinT, 1024, 0, 16, acc, smem);
    else gemm_std<PMODE>(p.XN, 1024, mt * 128, p.WinT, 1024, nt * 128, 16, acc, smem);
    if (PMODE != 0 && p.ctr[40] == 0) continue;
    EPI_COORDS
#pragma unroll
    for (int mi = 0; mi < 4; ++mi)
#pragma unroll
      for (int ni = 0; ni < 4; ++ni) {
        const int row = mt * 128 + wm * 64 + mi * 16 + r, col = nt * 128 + wn * 64 + ni * 16 + q * 4;
        uint2 pk; pk.x = pack2(acc[mi][ni][0], acc[mi][ni][1]); pk.y = pack2(acc[mi][ni][2], acc[mi][ni][3]);
        *(uint2*)(p.PROJ + (size_t)row * NPROJ + col) = pk;
      }
  }
}

DI void s5_disc(const Params& p, int g, int n, float& abr, float& abi, float& fre, float& fim) {
  const float ar = p.a_re[g * 64 + n], ai = p.a_im[g * 64 + n], dt = expf(p.log_dt[g]);
  const float mag = expf(ar * dt);
  float sn, cs; sincosf(ai * dt, &sn, &cs);
  abr = mag * cs; abi = mag * sn;
  const float den = ar * ar + ai * ai, pp = abr - 1.f;
  fre = (pp * ar + abi * ai) / den; fim = (abi * ar - pp * ai) / den;
}

__device__ void s5_scan_item(const Params& p, int item, char* smem) {
  const int b = item >> 5, g = item & 31;
  float* Xs = (float*)smem;
  bf16_t* Hs = (bf16_t*)(smem + 32768);
  bf16_t* Us = (bf16_t*)(smem + 32768 + 17408);
  const int t = threadIdx.x, lane = t & 63, w = t >> 6, r = lane & 15, q = lane >> 4;
  for (int i = t; i < 64 * 40; i += 256) Us[i] = 0;
  bf16x8 bfrag[2];
#pragma unroll
  for (int x = 0; x < 2; ++x) {
    const int np = (2 * w + x) * 16 + r, n = np >> 1, part = np & 1;
    float abr, abi, fre, fim; s5_disc(p, g, n, abr, abi, fre, fim);
#pragma unroll
    for (int jj = 0; jj < 8; ++jj) {
      float val = 0.f;
      if (q < 2) {
        const int c = q * 8 + jj;
        const float br = p.b_re[(size_t)(g * 64 + n) * 16 + c], bi = p.b_im[(size_t)(g * 64 + n) * 16 + c];
        val = part == 0 ? fre * br - fim * bi : fre * bi + fim * br;
      }
      bfrag[x][jj] = (short)f2bf(val);
    }
  }
  bf16x8 cfrag[4];
#pragma unroll
  for (int ks = 0; ks < 4; ++ks)
#pragma unroll
    for (int jj = 0; jj < 8; ++jj) {
      const int k = ks * 32 + q * 8 + jj;
      const float val = (k & 1) == 0 ? p.c_re[(size_t)(g * 16 + r) * 64 + (k >> 1)] : -p.c_im[(size_t)(g * 16 + r) * 64 + (k >> 1)];
      cfrag[ks][jj] = (short)f2bf(val);
    }
  float abr, abi, hr = 0.f, hi = 0.f;
  { float fre, fim; s5_disc(p, g, lane, abr, abi, fre, fim); }
  const float4 dco = *(const float4*)(p.s5_d + g * 16 + q * 4);
  __syncthreads();
  u32x4 unext = u32x4{0u, 0u, 0u, 0u};
  if (t < 128) unext = *(const u32x4*)(p.PROJ + ((size_t)b * 2048 + (t >> 1)) * NPROJ + g * 16 + (t & 1) * 8);
  for (int ch = 0; ch < 32; ++ch) {
    const size_t tok0 = (size_t)b * 2048 + ch * 64;
    if (t < 128) {
      *(u32x4*)(Us + (t >> 1) * 40 + (t & 1) * 8) = unext;
      if (ch + 1 < 32) unext = *(const u32x4*)(p.PROJ + (tok0 + 64 + (t >> 1)) * NPROJ + g * 16 + (t & 1) * 8);
    }
    lds_barrier();
    {
      bf16x8 af[4];
#pragma unroll
      for (int mt = 0; mt < 4; ++mt) af[mt] = *(const bf16x8*)(Us + (mt * 16 + r) * 40 + q * 8);
#pragma unroll
      for (int x = 0; x < 2; ++x)
#pragma unroll
        for (int mt = 0; mt < 4; ++mt) {
          f32x4 z = f32x4{0.f, 0.f, 0.f, 0.f};
          z = mfma16(af[mt], bfrag[x], z);
          const int col = (2 * w + x) * 16 + r;
#pragma unroll
          for (int j = 0; j < 4; ++j) Xs[(mt * 16 + q * 4 + j) * 128 + col] = z[j];
        }
    }
    lds_barrier();
    if (w == 0) {
      for (int tb = 0; tb < 8; ++tb) {
        f32x2_t xv[8];
#pragma unroll
        for (int u = 0; u < 8; ++u) xv[u] = *(const f32x2_t*)(Xs + (tb * 8 + u) * 128 + 2 * lane);
#pragma unroll
        for (int u = 0; u < 8; ++u) {
          const float nr = abr * hr - abi * hi + xv[u][0], ni = abr * hi + abi * hr + xv[u][1];
          hr = nr; hi = ni;
          *(unsigned*)(Hs + (tb * 8 + u) * 136 + 2 * lane) = pack2(hr, hi);
        }
      }
    }
    lds_barrier();
    {
      f32x4 y = f32x4{0.f, 0.f, 0.f, 0.f};
#pragma unroll
      for (int ks = 0; ks < 4; ++ks) { const bf16x8 a = *(const bf16x8*)(Hs + (w * 16 + r) * 136 + ks * 32 + q * 8); y = mfma16(cfrag[ks], a, y); }
      const int tk = w * 16 + r;
      const uint2 ur = *(const uint2*)(Us + tk * 40 + q * 4);
      const float o0 = geluf_(y[0] + dco.x * bflo(ur.x)), o1 = geluf_(y[1] + dco.y * bfhi(ur.x));
      const float o2 = geluf_(y[2] + dco.z * bflo(ur.y)), o3 = geluf_(y[3] + dco.w * bfhi(ur.y));
      uint2 pk; pk.x = pack2(o0, o1); pk.y = pack2(o2, o3);
      *(uint2*)(p.ys5 + (tok0 + tk) * 512 + g * 16 + q * 4) = pk;
    }
    lds_barrier();
  }
  if (w == 0) { p.p_s5_re[(size_t)(b * 32 + g) * 64 + lane] = hr; p.p_s5_im[(size_t)(b * 32 + g) * 64 + lane] = hi; }
}

__device__ void s5_decode_item(const Params& p, int s, char* smem) {
  float* us = (float*)smem; float* hre = us + 512; float* him = hre + 2048;
  const int t = threadIdx.x; const size_t row = NTOK + s;
  __syncthreads();
  for (int i = t; i < 512; i += 256) us[i] = p.sproj[(size_t)s * NPROJ + i];
  __syncthreads();
  for (int gq = 0; gq < 8; ++gq) {
    const int g = gq * 4 + (t >> 6), n = t & 63;
    float abr, abi, fre, fim; s5_disc(p, g, n, abr, abi, fre, fim);
    const float* br = p.b_re + (size_t)(g * 64 + n) * 16; const float* bi = p.b_im + (size_t)(g * 64 + n) * 16;
    float bur = 0.f, bui = 0.f;
#pragma unroll
    for (int c = 0; c < 16; ++c) { const float u = us[g * 16 + c]; bur += br[c] * u; bui += bi[c] * u; }
    const float xr = fre * bur - fim * bui, xi = fre * bui + fim * bur;
    const size_t si = (size_t)(s * 32 + g) * 64 + n;
    const float h0r = p.st_s5_re[si], h0i = p.st_s5_im[si];
    const float hr = abr * h0r - abi * h0i + xr, hi = abr * h0i + abi * h0r + xi;
    p.s_s5_re[si] = hr; p.s_s5_im[si] = hi;
    hre[g * 64 + n] = hr; him[g * 64 + n] = hi;
  }
  __syncthreads();
  for (int o = t; o < 512; o += 256) {
    const int g = o >> 4;
    const float* cr = p.c_re + (size_t)o * 64; const float* ci = p.c_im + (size_t)o * 64;
    float y = 0.f;
    for (int n = 0; n < 64; ++n) y += cr[n] * hre[g * 64 + n] - ci[n] * him[g * 64 + n];
    y += p.s5_d[o] * us[o];
    p.ys5[row * 512 + o] = f2bf(geluf_(y));
  }
  __syncthreads();
}

__device__ void gdn_prep_item(const Params& p, int item, char* smem) {
  const int c = item & 31, h = (item >> 5) & 3, b = item >> 7;
  bf16_t* Kn = (bf16_t*)smem;
  bf16_t* Qn = (bf16_t*)(smem + 16384);
  float* Lm = (float*)(smem + 16384);
  bf16_t* Vs = (bf16_t*)(smem + 32768);
  float* gcs = (float*)(smem + 49152);
  float* bts = gcs + 64;
  float* egs = bts + 64;
  const int t = threadIdx.x, lane = t & 63, w = t >> 6, r = lane & 15, q = lane >> 4;
  const int tok0 = c * 64; const size_t row0 = (size_t)b * 2048 + tok0;
  bf16_t* gi = p.GDNI + (size_t)item * 36864;
  __syncthreads();
  if (w == 0) {
    const float* bar = p.ba + (row0 + lane) * 8;
    const float beta = sigmoidf_(bar[h]);
    const float xx = bar[4 + h] + p.dt_bias[h];
    const float sp = fmaxf(xx, 0.f) + log1pf(expf(-fabsf(xx)));
    float s = -expf(p.a_log[h]) * sp;
    for (int o = 1; o < 64; o <<= 1) { const float y = __shfl_up(s, o); if (lane >= o) s += y; }
    gcs[lane] = s; bts[lane] = beta; egs[lane] = expf(s);
  }
  __syncthreads();
  if (c == 31) {
    for (int idx = t; idx < 1152; idx += 256) {
      const int i = idx / 384, rem = idx % 384, X = rem >> 7, cc = rem & 127;
      const int col = X * 512 + h * 128 + cc;
      p.p_gdn_conv[(size_t)(b * 3 + i) * 1536 + col] = bf2f(p.PROJ[((size_t)b * 2048 + 2045 + i) * NPROJ + 512 + col]);
    }
  }
  {
    const int row = t >> 2, seg = t & 3;
    const float eg = egs[row], ekg = expf(gcs[63] - gcs[row]);
    const int tok = tok0 + row;
#pragma unroll
    for (int X = 0; X < 3; ++X) {
      float val[32]; float ss = 0.f;
      const int colbase = X * 512 + h * 128 + seg * 32;
#pragma unroll
      for (int cb = 0; cb < 4; ++cb) {
        float a8[8];
#pragma unroll
        for (int e = 0; e < 8; ++e) a8[e] = 0.f;
#pragma unroll
        for (int tap = 0; tap < 4; ++tap) {
          const int tk = tok - 3 + tap;
          if (tk >= 0) {
            const uint4 raw = *(const uint4*)(p.PROJ + ((size_t)b * 2048 + tk) * NPROJ + 512 + colbase + cb * 8);
            const float* wp = p.gdn_conv_w + tap * 1536 + colbase + cb * 8;
            const float4 w0 = *(const float4*)wp, w1 = *(const float4*)(wp + 4);
            a8[0] += bflo(raw.x) * w0.x; a8[1] += bfhi(raw.x) * w0.y; a8[2] += bflo(raw.y) * w0.z; a8[3] += bfhi(raw.y) * w0.w;
            a8[4] += bflo(raw.z) * w1.x; a8[5] += bfhi(raw.z) * w1.y; a8[6] += bflo(raw.w) * w1.z; a8[7] += bfhi(raw.w) * w1.w;
          }
        }
#pragma unroll
        for (int e = 0; e < 8; ++e) { const float v = siluf_(a8[e]); val[cb * 8 + e] = v; ss += v * v; }
        __builtin_amdgcn_sched_barrier(0);
      }
      if (X < 2) {
        ss += __shfl_xor(ss, 1); ss += __shfl_xor(ss, 2);
        const float sc = rsqrtf(ss + 1e-6f) * (X == 0 ? 0.08838834764831845f : 1.f);
#pragma unroll
        for (int e = 0; e < 32; ++e) val[e] *= sc;
      }
      if (X == 0) {
#pragma unroll
        for (int cb = 0; cb < 4; ++cb) {
          uint4 pk; pk.x = pack2(val[cb * 8], val[cb * 8 + 1]); pk.y = pack2(val[cb * 8 + 2], val[cb * 8 + 3]); pk.z = pack2(val[cb * 8 + 4], val[cb * 8 + 5]); pk.w = pack2(val[cb * 8 + 6], val[cb * 8 + 7]);
          *(uint4*)(Qn + row * 128 + (((seg * 4 + cb) ^ (row & 15)) * 8)) = pk;
          uint4 pg; pg.x = pack2(val[cb * 8] * eg, val[cb * 8 + 1] * eg); pg.y = pack2(val[cb * 8 + 2] * eg, val[cb * 8 + 3] * eg); pg.z = pack2(val[cb * 8 + 4] * eg, val[cb * 8 + 5] * eg); pg.w = pack2(val[cb * 8 + 6] * eg, val[cb * 8 + 7] * eg);
          *(uint4*)(gi + 16384 + row * 128 + seg * 32 + cb * 8) = pg;
        }
      } else if (X == 1) {
#pragma unroll
        for (int cb = 0; cb < 4; ++cb) {
          uint4 pk; pk.x = pack2(val[cb * 8], val[cb * 8 + 1]); pk.y = pack2(val[cb * 8 + 2], val[cb * 8 + 3]); pk.z = pack2(val[cb * 8 + 4], val[cb * 8 + 5]); pk.w = pack2(val[cb * 8 + 6], val[cb * 8 + 7]);
          *(uint4*)(Kn + row * 128 + (((seg * 4 + cb) ^ (row & 15)) * 8)) = pk;
        }
#pragma unroll
        for (int e = 0; e < 32; ++e) gi[24576 + (seg * 32 + e) * 64 + row] = f2bf(val[e] * ekg);
      } else {
#pragma unroll
        for (int cb = 0; cb < 4; ++cb) {
          uint4 pk; pk.x = pack2(val[cb * 8], val[cb * 8 + 1]); pk.y = pack2(val[cb * 8 + 2], val[cb * 8 + 3]); pk.z = pack2(val[cb * 8 + 4], val[cb * 8 + 5]); pk.w = pack2(val[cb * 8 + 6], val[cb * 8 + 7]);
          *(uint4*)(Vs + row * 128 + seg * 32 + cb * 8) = pk;
        }
      }
    }
  }
  __syncthreads();
  f32x4 kk[4], qk[4];
  {
    bf16x8 ak[4], aq[4];
    const int rowA = w * 16 + r;
#pragma unroll
    for (int ks = 0; ks < 4; ++ks) { const int phys = (ks * 4 + q) ^ r; ak[ks] = *(const bf16x8*)(Kn + rowA * 128 + phys * 8); aq[ks] = *(const bf16x8*)(Qn + rowA * 128 + phys * 8); }
#pragma unroll
    for (int nt = 0; nt < 4; ++nt) {
      kk[nt] = f32x4{0.f, 0.f, 0.f, 0.f}; qk[nt] = f32x4{0.f, 0.f, 0.f, 0.f};
      if (nt <= w) {
        const int rowB = nt * 16 + r;
#pragma unroll
        for (int ks = 0; ks < 4; ++ks) {
          const int phys = (ks * 4 + q) ^ r;
          const bf16x8 bb = *(const bf16x8*)(Kn + rowB * 128 + phys * 8);
          kk[nt] = mfma16(ak[ks], bb, kk[nt]); qk[nt] = mfma16(aq[ks], bb, qk[nt]);
        }
      }
    }
  }
  __syncthreads();
#pragma unroll
  for (int nt = 0; nt < 4; ++nt)
#pragma unroll
    for (int j = 0; j < 4; ++j) {
      const int i = w * 16 + q * 4 + j, jc = nt * 16 + r;
      const float dec = __expf(fminf(gcs[i] - gcs[jc], 0.f));
      Lm[i * 64 + jc] = (i > jc) ? bts[i] * kk[nt][j] * dec : 0.f;
      gi[32768 + i * 64 + jc] = f2bf((i >= jc) ? qk[nt][j] * dec : 0.f);
    }
  __syncthreads();
  {
    float sol[64];
    const bool isv = t < 128;
    const int kc = t - 128;
    if (isv) {
#pragma unroll
      for (int i = 0; i < 64; ++i) { sol[i] = bf2f(Vs[i * 128 + t]) * bts[i]; if ((i & 7) == 7) __builtin_amdgcn_sched_barrier(0); }
    } else {
#pragma unroll
      for (int i = 0; i < 64; ++i) { sol[i] = bf2f(Kn[i * 128 + (((kc >> 3) ^ (i & 15)) * 8) + (kc & 7)]) * bts[i] * egs[i]; if ((i & 7) == 7) __builtin_amdgcn_sched_barrier(0); }
    }
    __builtin_amdgcn_sched_barrier(0);
#pragma unroll
    for (int i = 1; i < 64; ++i) {
      float a = sol[i];
#pragma unroll
      for (int jb = 0; jb < (i + 3) / 4; ++jb) {
        const float4 l = *(const float4*)(Lm + i * 64 + jb * 4);
        if (jb * 4 + 0 < i) a -= l.x * sol[jb * 4 + 0];
        if (jb * 4 + 1 < i) a -= l.y * sol[jb * 4 + 1];
        if (jb * 4 + 2 < i) a -= l.z * sol[jb * 4 + 2];
        if (jb * 4 + 3 < i) a -= l.w * sol[jb * 4 + 3];
      }
      sol[i] = a;
      __builtin_amdgcn_sched_barrier(0);
    }
    bf16_t* go = gi + t + (isv ? 0 : 8192 - 128);
#pragma unroll
    for (int i = 0; i < 64; ++i) { go[i * 128] = f2bf(sol[i]); if ((i & 7) == 7) __builtin_amdgcn_sched_barrier(0); }
  }
  if (t == 0) p.glast[item] = egs[63];
}

__device__ void gdn_decode_item(const Params& p, int item, char* smem) {
  const int h = item & 3, s = item >> 2; const size_t row = NTOK + s;
  float* qs = (float*)smem; float* ks = qs + 128; float* vs = ks + 128; float* part = vs + 128; float* red = part + 512;
  const int t = threadIdx.x;
  __syncthreads();
  float cv[3] = {0.f, 0.f, 0.f};
  if (t < 128) {
#pragma unroll
    for (int X = 0; X < 3; ++X) {
      const int col = X * 512 + h * 128 + t;
      const float* buf = p.st_gdn_conv + (size_t)s * 3 * 1536 + col;
      const float b0 = buf[0], b1 = buf[1536], b2 = buf[3072];
      const float nw = p.sproj[(size_t)s * NPROJ + 512 + col];
      const float* cw = p.gdn_conv_w + col;
      const float a = b0 * cw[0] + b1 * cw[1536] + b2 * cw[3072] + nw * cw[4608];
      cv[X] = siluf_(a);
      float* ob = p.s_gdn_conv + (size_t)s * 3 * 1536 + col;
      ob[0] = b1; ob[1536] = b2; ob[3072] = nw;
    }
  }
  const float sq = block_sum(cv[0] * cv[0], red), sk = block_sum(cv[1] * cv[1], red);
  const float qn = cv[0] * rsqrtf(sq + 1e-6f) * 0.08838834764831845f, kn = cv[1] * rsqrtf(sk + 1e-6f);
  const float qk = block_sum(qn * kn, red);
  if (t < 128) { qs[t] = qn; ks[t] = kn; vs[t] = cv[2]; }
  const float beta = sigmoidf_(p.ba[row * 8 + h]);
  const float xx = p.ba[row * 8 + 4 + h] + p.dt_bias[h];
  const float eg = expf(-expf(p.a_log[h]) * (fmaxf(xx, 0.f) + log1pf(expf(-fabsf(xx)))));
  __syncthreads();
  const int e = t & 127, dh = t >> 7;
  const size_t soff = ((size_t)(s * 4 + h) * 128 + dh * 64) * 128 + e;
  const float* S0 = p.st_gdn + soff;
  float sr[64]; float kS = 0.f, qS = 0.f;
#pragma unroll
  for (int d = 0; d < 64; ++d) { sr[d] = S0[(size_t)d * 128]; kS += ks[dh * 64 + d] * sr[d]; qS += qs[dh * 64 + d] * sr[d]; }
  part[dh * 128 + e] = kS; part[256 + dh * 128 + e] = qS;
  __syncthreads();
  kS = part[e] + part[128 + e]; qS = part[256 + e] + part[384 + e];
  const float vn = beta * (vs[e] - eg * kS);
  const float o = eg * qS + qk * vn;
  float* S1 = p.s_gdn + soff;
#pragma unroll
  for (int d = 0; d < 64; ++d) S1[(size_t)d * 128] = sr[d] * eg + ks[dh * 64 + d] * vn;
  const float so = block_sum(dh == 0 ? o * o : 0.f, red);
  if (dh == 0) {
    const float z = p.sproj[(size_t)s * NPROJ + 2048 + h * 128 + e];
    p.XN[row * 1024 + 512 + h * 128 + e] = f2bf(o * rsqrtf(so * (1.f / 128.f) + 1e-6f) * p.onorm_g[e] * siluf_(z));
  }
  __syncthreads();
}

#ifndef REP_MASK
#define REP_MASK 15
#endif
template <int MASK>
DI void phase2(const Params& p, char* smem, int cofs) {
  constexpr int N_S5 = 256, N_PREP = 1024, N_SDEC = 128;
  for (;;) {
    int it = fetch_item(p.ctr + 2 + cofs);
    if (it >= N_S5 + N_PREP + N_SDEC) break;
    if (it < N_S5) { if (MASK & 1) s5_scan_item(p, it, smem); continue; }
    it -= N_S5;
    if (it < N_PREP) { if (MASK & 2) gdn_prep_item(p, it, smem); continue; }
    it -= N_PREP;
    if (MASK & 8) s5_decode_item(p, it, smem);
  }
}

__device__ void gdn_seq_item(const Params& p, int item, char* smem) {
  const int sl = item & 3, h = (item >> 2) & 3, b = item >> 4;
  bf16_t* ST = (bf16_t*)smem;
  bf16_t* VT = (bf16_t*)(smem + 8704);
  const int t = threadIdx.x, lane = t & 63, w = t >> 6, r = lane & 15, q = lane >> 4;
  __syncthreads();
  for (int i = t; i < 32 * 136; i += 256) ST[i] = 0;
  f32x4 sacc[2][2];
#pragma unroll
  for (int mi = 0; mi < 2; ++mi)
#pragma unroll
    for (int ni = 0; ni < 2; ++ni) sacc[mi][ni] = f32x4{0.f, 0.f, 0.f, 0.f};
  bf16x8 W0[4], Q0[4], A0[2], K0[2][2];
  unsigned U0[2][4]; float g0;
  const bf16_t* gbase = p.GDNI + (size_t)((b * 4 + h) * 32) * 36864;
  const float* glb = p.glast + (b * 4 + h) * 32;
#define SEQ_LOAD_WQU(S, C) { \
    const bf16_t* gi_ = gbase + (size_t)(C) * 36864; \
    _Pragma("unroll") for (int ks = 0; ks < 4; ++ks) { \
      W##S[ks] = *(const bf16x8*)(gi_ + 8192 + (w * 16 + r) * 128 + ks * 32 + q * 8); \
      Q##S[ks] = *(const bf16x8*)(gi_ + 16384 + (w * 16 + r) * 128 + ks * 32 + q * 8); } \
    _Pragma("unroll") for (int ni = 0; ni < 2; ++ni) _Pragma("unroll") for (int j = 0; j < 4; ++j) \
      U##S[ni][j] = (unsigned)gi_[(w * 16 + q * 4 + j) * 128 + sl * 32 + ni * 16 + r]; \
    g##S = glb[(C)]; }
#define SEQ_LOAD_AK(S, C) { \
    const bf16_t* gi_ = gbase + (size_t)(C) * 36864; \
    _Pragma("unroll") for (int k2 = 0; k2 < 2; ++k2) { \
      A##S[k2] = *(const bf16x8*)(gi_ + 32768 + (w * 16 + r) * 64 + k2 * 32 + q * 8); \
      _Pragma("unroll") for (int mi = 0; mi < 2; ++mi) K##S[mi][k2] = *(const bf16x8*)(gi_ + 24576 + ((2 * w + mi) * 16 + r) * 64 + k2 * 32 + q * 8); } }
#define SEQ_CHUNK(S, C) { \
    f32x4 vacc[2], oacc[2]; \
    _Pragma("unroll") for (int ni = 0; ni < 2; ++ni) { vacc[ni] = f32x4{0.f, 0.f, 0.f, 0.f}; oacc[ni] = f32x4{0.f, 0.f, 0.f, 0.f}; } \
    _Pragma("unroll") for (int ks = 0; ks < 4; ++ks) { \
      _Pragma("unroll") for (int ni = 0; ni < 2; ++ni) { \
        const bf16x8 bs = *(const bf16x8*)(ST + (ni * 16 + r) * 136 + ks * 32 + q * 8); \
        vacc[ni] = mfma16(W0[ks], bs, vacc[ni]); oacc[ni] = mfma16(bs, Q0[ks], oacc[ni]); } } \
    _Pragma("unroll") for (int ni = 0; ni < 2; ++ni) { \
      float vn[4]; \
      _Pragma("unroll") for (int j = 0; j < 4; ++j) vn[j] = __uint_as_float(U0[ni][j] << 16) - vacc[ni][j]; \
      uint2 pk; pk.x = pack2(vn[0], vn[1]); pk.y = pack2(vn[2], vn[3]); \
      *(uint2*)(VT + (ni * 16 + r) * 72 + w * 16 + q * 4) = pk; } \
    const float gl = g0; \
    __builtin_amdgcn_sched_barrier(0); \
    if ((C) + 1 < 32) SEQ_LOAD_WQU(0, (C) + 1) \
    __builtin_amdgcn_sched_barrier(0); \
    lds_barrier(); \
    bf16x8 bv[2][2]; \
    _Pragma("unroll") for (int ni = 0; ni < 2; ++ni) _Pragma("unroll") for (int k2 = 0; k2 < 2; ++k2) bv[ni][k2] = *(const bf16x8*)(VT + (ni * 16 + r) * 72 + k2 * 32 + q * 8); \
    _Pragma("unroll") for (int k2 = 0; k2 < 2; ++k2) _Pragma("unroll") for (int ni = 0; ni < 2; ++ni) oacc[ni] = mfma16(bv[ni][k2], A0[k2], oacc[ni]); \
    _Pragma("unroll") for (int mi = 0; mi < 2; ++mi) { \
      _Pragma("unroll") for (int ni = 0; ni < 2; ++ni) sacc[mi][ni] *= gl; \
      _Pragma("unroll") for (int k2 = 0; k2 < 2; ++k2) _Pragma("unroll") for (int ni = 0; ni < 2; ++ni) sacc[mi][ni] = mfma16(K0[mi][k2], bv[ni][k2], sacc[mi][ni]); } \
    __builtin_amdgcn_sched_barrier(0); \
    if ((C) + 1 < 32) SEQ_LOAD_AK(0, (C) + 1) \
    __builtin_amdgcn_sched_barrier(0); \
    _Pragma("unroll") for (int ni = 0; ni < 2; ++ni) { \
      float4 o; o.x = oacc[ni][0]; o.y = oacc[ni][1]; o.z = oacc[ni][2]; o.w = oacc[ni][3]; \
      *(float4*)(p.ogdn + ((size_t)b * 2048 + (C) * 64 + w * 16 + r) * 512 + h * 128 + sl * 32 + ni * 16 + q * 4) = o; } \
    _Pragma("unroll") for (int mi = 0; mi < 2; ++mi) _Pragma("unroll") for (int ni = 0; ni < 2; ++ni) { \
      uint2 pk; pk.x = pack2(sacc[mi][ni][0], sacc[mi][ni][1]); pk.y = pack2(sacc[mi][ni][2], sacc[mi][ni][3]); \
      *(uint2*)(ST + (ni * 16 + r) * 136 + (2 * w + mi) * 16 + q * 4) = pk; } \
    lds_barrier(); }
  SEQ_LOAD_WQU(0, 0)
  SEQ_LOAD_AK(0, 0)
  __syncthreads();
  for (int c = 0; c < 32; c += 2) {
    SEQ_CHUNK(0, c)
    SEQ_CHUNK(1, c + 1)
  }
#undef SEQ_LOAD_WQU
#undef SEQ_LOAD_AK
#undef SEQ_CHUNK
#pragma unroll
  for (int mi = 0; mi < 2; ++mi)
#pragma unroll
    for (int ni = 0; ni < 2; ++ni)
#pragma unroll
      for (int j = 0; j < 4; ++j)
        p.p_gdn[((size_t)(b * 4 + h) * 128 + (2 * w + mi) * 16 + q * 4 + j) * 128 + sl * 32 + ni * 16 + r] = sacc[mi][ni][j];
}

__device__ void glu_tile(const Params& p, int idx, char* smem) {
  const int mt = idx >> 3, nt = idx & 7;
  f32x4 acc[4][4];
  gemm_std(p.ys5, 512, mt * 128, p.WgluT, 512, nt * 128, 8, acc, smem);
  EPI_COORDS
#pragma unroll
  for (int mi = 0; mi < 4; ++mi)
#pragma unroll
    for (int ni = 0; ni < 2; ++ni) {
      const int row = mt * 128 + wm * 64 + mi * 16 + r, col = nt * 64 + wn * 32 + ni * 16 + q * 4;
      float o[4];
#pragma unroll
      for (int j = 0; j < 4; ++j) o[j] = acc[mi][ni][j] * sigmoidf_(acc[mi][ni + 2][j]);
      uint2 pk; pk.x = pack2(o[0], o[1]); pk.y = pack2(o[2], o[3]);
      *(uint2*)(p.XN + (size_t)row * 1024 + col) = pk;
    }
}

template <int MASK>
DI void phase3(const Params& p, char* smem, int cofs) {
  constexpr int N_SEQ = 128, N_GLU = 129 * 8, N_GDEC = 512;
  for (;;) {
    int it = fetch_item(p.ctr + 3 + cofs);
    if (it >= N_SEQ + N_GLU + N_GDEC) break;
    if (it < N_SEQ) { if (MASK & 1) gdn_seq_item(p, it, smem); }
    else if (it < N_SEQ + N_GLU) { if (MASK & 2) glu_tile(p, it - N_SEQ, smem); }
    else { if (MASK & 2) gdn_decode_item(p, it - N_SEQ - N_GLU, smem); }
  }
}

__device__ void phase4(const Params& p) {
  const int lane = threadIdx.x & 63, w = threadIdx.x >> 6;
  for (int i = blockIdx.x * 256 + threadIdx.x; i < 128 * 1024 / 4; i += gridDim.x * 256)
    *(float4*)(p.out + (size_t)NTOK * 1024 + (size_t)i * 4) = *(const float4*)(p.x_sample + (size_t)i * 4);
  for (int it = blockIdx.x; it < NTOK / 4; it += gridDim.x) {
    const size_t row = (size_t)it * 4 + w;
    const float* op = p.ogdn + row * 512 + lane * 8;
    const float4 o0 = *(const float4*)op, o1 = *(const float4*)(op + 4);
    float ss = o0.x * o0.x + o0.y * o0.y + o0.z * o0.z + o0.w * o0.w + o1.x * o1.x + o1.y * o1.y + o1.z * o1.z + o1.w * o1.w;
    ss += __shfl_xor(ss, 1); ss += __shfl_xor(ss, 2); ss += __shfl_xor(ss, 4); ss += __shfl_xor(ss, 8);
    const float rs = rsqrtf(ss * (1.f / 128.f) + 1e-6f);
    const uint4 zr = *(const uint4*)(p.PROJ + row * NPROJ + 2048 + lane * 8);
    const float* gp = p.onorm_g + (lane & 15) * 8;
    const float4 g0 = *(const float4*)gp, g1 = *(const float4*)(gp + 4);
    uint4 pk;
    pk.x = pack2(o0.x * rs * g0.x * siluf_(bflo(zr.x)), o0.y * rs * g0.y * siluf_(bfhi(zr.x)));
    pk.y = pack2(o0.z * rs * g0.z * siluf_(bflo(zr.y)), o0.w * rs * g0.w * siluf_(bfhi(zr.y)));
    pk.z = pack2(o1.x * rs * g1.x * siluf_(bflo(zr.z)), o1.y * rs * g1.y * siluf_(bfhi(zr.z)));
    pk.w = pack2(o1.z * rs * g1.z * siluf_(bflo(zr.w)), o1.w * rs * g1.w * siluf_(bfhi(zr.w)));
    *(uint4*)(p.XN + row * 1024 + 512 + lane * 8) = pk;
  }
}

__device__ void phase5(const Params& p, char* smem, int vb) {
  for (int step = 0;; ++step) {
    int mt, nt; bool valid;
    if (!get_tile(vb, step, 128, 8, 8, mt, nt, valid)) break;
    if (!valid) continue;
    f32x4 acc[4][4];
    gemm_std(p.XN, 1024, mt * 128, p.WoutT, 1024, nt * 128, 16, acc, smem);
    EPI_COORDS
#pragma unroll
    for (int mi = 0; mi < 4; ++mi) {
      const int row = mt * 128 + wm * 64 + mi * 16 + r;
      const float* xr = xin_row(p, row);
      float4 xv[4];
#pragma unroll
      for (int ni = 0; ni < 4; ++ni) xv[ni] = *(const float4*)(xr + nt * 128 + wn * 64 + ni * 16 + q * 4);
#pragma unroll
      for (int ni = 0; ni < 4; ++ni) {
        float4 o; o.x = xv[ni].x + acc[mi][ni][0]; o.y = xv[ni].y + acc[mi][ni][1]; o.z = xv[ni].z + acc[mi][ni][2]; o.w = xv[ni].w + acc[mi][ni][3];
        *(float4*)(p.out + (size_t)row * 1024 + nt * 128 + wn * 64 + ni * 16 + q * 4) = o;
      }
    }
  }
  if (vb < 32) sample_splitk_task(p.out + (size_t)NTOK * 1024, 1024, p.XN, 1024, p.WoutT, 1024, vb & 7, vb >> 3, smem);
}

__device__ void phase_norm(const Params& p, bool final_) {
  const int lane = threadIdx.x & 63, w = threadIdx.x >> 6;
  const float* gw = final_ ? p.normf_g : p.norm2_g;
  float4 g[4];
#pragma unroll
  for (int i = 0; i < 4; ++i) g[i] = *(const float4*)(gw + i * 256 + lane * 4);
  for (int it = blockIdx.x; it < MROWS / 8; it += gridDim.x) {
    float4 v[2][4];
#pragma unroll
    for (int rr = 0; rr < 2; ++rr)
#pragma unroll
      for (int i = 0; i < 4; ++i) v[rr][i] = *(const float4*)(p.out + ((size_t)it * 8 + rr * 4 + w) * 1024 + i * 256 + lane * 4);
#pragma unroll
    for (int rr = 0; rr < 2; ++rr) {
      const size_t row = (size_t)it * 8 + rr * 4 + w;
      float* xr = p.out + row * 1024;
      float ss = 0.f;
#pragma unroll
      for (int i = 0; i < 4; ++i) ss += v[rr][i].x * v[rr][i].x + v[rr][i].y * v[rr][i].y + v[rr][i].z * v[rr][i].z + v[rr][i].w * v[rr][i].w;
      ss = wave_sum(ss);
      const float rstd = rsqrtf(ss * (1.f / 1024.f) + 1e-6f);
#pragma unroll
      for (int i = 0; i < 4; ++i) {
        float4 o; o.x = v[rr][i].x * rstd * g[i].x; o.y = v[rr][i].y * rstd * g[i].y; o.z = v[rr][i].z * rstd * g[i].z; o.w = v[rr][i].w * rstd * g[i].w;
        if (final_) *(float4*)(xr + i * 256 + lane * 4) = o;
        else { uint2 pk; pk.x = pack2(o.x, o.y); pk.y = pack2(o.z, o.w); *(uint2*)(p.XN + row * 1024 + i * 256 + lane * 4) = pk; }
      }
    }
  }
}

__device__ void phase7(const Params& p, char* smem, int vb) {
  constexpr int NT = 44, MT = 137;
  float* hl = (float*)smem;
  for (int step = 0;; ++step) {
    int mt, nt;
    if (!get_tile_strip(vb, step, MT, NT, 4, mt, nt)) break;
    const bool samp = mt == 136;
    const int bb = mt / 17, ii = mt % 17;
    f32x4 acc[4][4];
    {
      const int t = threadIdx.x;
      unsigned amask = 0;
      long arow0;
      if (samp) { arow0 = NTOK + (t >> 3); amask = 0xfu; }
      else {
        arow0 = (long)bb * 2048 + 126 * ii - 2 + (t >> 3);
#pragma unroll
        for (int i = 0; i < 4; ++i) { const int tok = 126 * ii - 2 + (t >> 3) + 32 * i; if (tok >= 0 && tok < 2048) amask |= 1u << i; }
      }
      const bf16_t* a0 = p.XN + arow0 * 1024 + (t & 7) * 8;
      const bf16_t* b0 = p.WupT + (size_t)(nt * 128 + (t >> 3)) * 1024 + (t & 7) * 8;
      gemm_main<true>(a0, (size_t)32 * 1024, amask, b0, (size_t)32 * 1024, 16, acc, smem);
    }
    EPI_COORDS
    __syncthreads();
#pragma unroll
    for (int mi = 0; mi < 4; ++mi)
#pragma unroll
      for (int ni = 0; ni < 4; ++ni)
#pragma unroll
        for (int j = 0; j < 4; ++j) hl[(wm * 64 + mi * 16 + r) * 132 + wn * 64 + ni * 16 + q * 4 + j] = acc[mi][ni][j];
    __syncthreads();
    {
      const int jp = t & 31, rbase = (t >> 5) * 16;
      const int hsel = jp >> 4, lc = hsel * 64 + 2 * (jp & 15);
      const int colp = nt * 64 + hsel * 32 + 2 * (jp & 15);
      const float2 wg0 = *(const float2*)(p.ffn_conv_w + colp), wg1 = *(const float2*)(p.ffn_conv_w + 5632 + colp), wg2 = *(const float2*)(p.ffn_conv_w + 2 * 5632 + colp);
      const float2 wu0 = *(const float2*)(p.ffn_conv_w + 2816 + colp), wu1 = *(const float2*)(p.ffn_conv_w + 5632 + 2816 + colp), wu2 = *(const float2*)(p.ffn_conv_w + 2 * 5632 + 2816 + colp);
      if (samp) {
#pragma unroll 2
        for (int rr = 0; rr < 16; ++rr) {
          const int sidx = rbase + rr;
          const float* sb = p.st_ffn_conv + (size_t)sidx * 2 * 5632;
          const float2 g0 = *(const float2*)(sb + colp), g1 = *(const float2*)(sb + 5632 + colp), u0 = *(const float2*)(sb + 2816 + colp), u1 = *(const float2*)(sb + 5632 + 2816 + colp);
          const float2 hg = *(const float2*)(hl + sidx * 132 + lc), hu = *(const float2*)(hl + sidx * 132 + lc + 32);
          const float ga = g0.x * wg0.x + g1.x * wg1.x + hg.x * wg2.x, gb = g0.y * wg0.y + g1.y * wg1.y + hg.y * wg2.y;
          const float ua = u0.x * wu0.x + u1.x * wu1.x + hu.x * wu2.x, ub = u0.y * wu0.y + u1.y * wu1.y + hu.y * wu2.y;
          *(unsigned*)(p.ACT + (size_t)(NTOK + sidx) * 2816 + colp) = pack2(siluf_(ga) * ua, siluf_(gb) * ub);
          float* ob = p.s_ffn_conv + (size_t)sidx * 2 * 5632;
          *(float2*)(ob + colp) = g1; *(float2*)(ob + 2816 + colp) = u1; *(float2*)(ob + 5632 + colp) = hg; *(float2*)(ob + 5632 + 2816 + colp) = hu;
        }
      } else {
        float2 ga = make_float2(0.f, 0.f), gb = ga, ua = ga, ub = ga;
        if (rbase >= 2) {
          ga = *(const float2*)(hl + (rbase - 2) * 132 + lc); gb = *(const float2*)(hl + (rbase - 1) * 132 + lc);
          ua = *(const float2*)(hl + (rbase - 2) * 132 + lc + 32); ub = *(const float2*)(hl + (rbase - 1) * 132 + lc + 32);
        }
#pragma unroll 4
        for (int rr = 0; rr < 16; ++rr) {
          const int rowt = rbase + rr;
          const int tok = 126 * ii - 2 + rowt;
          float2 gc = *(const float2*)(hl + rowt * 132 + lc), uc = *(const float2*)(hl + rowt * 132 + lc + 32);
          if (tok < 0) { gc = make_float2(0.f, 0.f); uc = gc; }
          if (rowt >= 2 && tok < 2048) {
            const float g0 = ga.x * wg0.x + gb.x * wg1.x + gc.x * wg2.x, g1 = ga.y * wg0.y + gb.y * wg1.y + gc.y * wg2.y;
            const float u0 = ua.x * wu0.x + ub.x * wu1.x + uc.x * wu2.x, u1 = ua.y * wu0.y + ub.y * wu1.y + uc.y * wu2.y;
            *(unsigned*)(p.ACT + ((size_t)bb * 2048 + tok) * 2816 + colp) = pack2(siluf_(g0) * u0, siluf_(g1) * u1);
            if (tok >= 2046) {
              float* ob = p.p_ffn_conv + (size_t)(bb * 2 + (tok - 2046)) * 5632;
              *(float2*)(ob + colp) = gc; *(float2*)(ob + 2816 + colp) = uc;
            }
          }
          ga = gb; gb = gc; ua = ub; ub = uc;
        }
      }
    }
  }
}

__device__ void phase8(const Params& p, char* smem, int vb) {
  for (int step = 0;; ++step) {
    int mt, nt; bool valid;
    if (!get_tile(vb, step, 128, 8, 8, mt, nt, valid)) break;
    if (!valid) continue;
    f32x4 acc[4][4];
    gemm_std(p.ACT, 2816, mt * 128, p.WdnT, 2816, nt * 128, 44, acc, smem);
    EPI_COORDS
#pragma unroll
    for (int mi = 0; mi < 4; ++mi) {
      float* orow = p.out + (size_t)(mt * 128 + wm * 64 + mi * 16 + r) * 1024 + nt * 128 + wn * 64 + q * 4;
      float4 xv[4];
#pragma unroll
      for (int ni = 0; ni < 4; ++ni) xv[ni] = *(const float4*)(orow + ni * 16);
#pragma unroll
      for (int ni = 0; ni < 4; ++ni) {
        float4 o; o.x = xv[ni].x + acc[mi][ni][0]; o.y = xv[ni].y + acc[mi][ni][1]; o.z = xv[ni].z + acc[mi][ni][2]; o.w = xv[ni].w + acc[mi][ni][3];
        *(float4*)(orow + ni * 16) = o;
      }
    }
  }
  if (vb < 88) sample_splitk_task(p.out + (size_t)NTOK * 1024, 1024, p.ACT, 2816, p.WdnT, 2816, vb & 7, vb >> 3, smem);
}

template <int PH>
DI void run_phase(const Params& p, char* smem, int vb, int cofs = 0) {
  if (PH == 0) phase0(p, smem);
  else if (PH == 1) { if (cofs) phase1<REP_MODE + 10 * 0>(p, smem, vb); else phase1<0>(p, smem, vb); }
  else if (PH == 2) { if (cofs) phase2<REP_MASK>(p, smem, cofs); else phase2<15>(p, smem, 0); }
  else if (PH == 3) { if (cofs) phase3<(REP_MASK & 3)>(p, smem, cofs); else phase3<3>(p, smem, 0); }
  else if (PH == 4) phase4(p);
  else if (PH == 5) phase5(p, smem, vb);
  else if (PH == 6) phase_norm(p, false);
  else if (PH == 7) phase7(p, smem, vb);
  else if (PH == 8) phase8(p, smem, vb);
  else phase_norm(p, true);
}

template <int PH>
__global__ void __launch_bounds__(256, 2) phase_kernel(Params p) {
  __shared__ __attribute__((aligned(16))) char smem[SMEM_BYTES];
  run_phase<PH>(p, smem, blockIdx.x);
}


#define XB_TMO      128
#define XB_XCNT(j)  (256  + 64 * (j))
#define XB_XSUB(j)  (1280 + 64 * (j))
#define XB_XGEN(j)  (2304 + 64 * (j))
#define XB_TOP      3328
#define XB_TOPGEN   3392
#define XCD_BAR_WORDS 3456
#define XB_SPIN_CAP (1u << 18)
#define LAS __attribute__((address_space(3)))
DI unsigned xb_ld(unsigned* p) { return __hip_atomic_load(p, __ATOMIC_RELAXED, __HIP_MEMORY_SCOPE_AGENT); }
DI unsigned xb_add(unsigned* p, unsigned v) { return __hip_atomic_fetch_add(p, v, __ATOMIC_RELAXED, __HIP_MEMORY_SCOPE_AGENT); }
DI unsigned xb_xcc_id() { return (unsigned)__builtin_amdgcn_s_getreg((3 << 11) | 20) & 0xFu; }
#define XB_SPIN(cond, bar) do { unsigned _sp = 0; while (cond) { __builtin_amdgcn_s_sleep(1); \
    if ((++_sp & 255u) == 0u) { if (xb_ld(&(bar)[XB_TMO])) break; if (_sp > XB_SPIN_CAP) { atomicAdd(&(bar)[XB_TMO], 1u); break; } } } } while (0)
struct XcdBarrier { unsigned* bar; unsigned x; volatile LAS unsigned* st; };
DI XcdBarrier xcd_barrier_post(unsigned* bar, volatile LAS unsigned* st) {
  XcdBarrier b; b.bar = bar; b.x = xb_xcc_id(); b.st = st;
  if (threadIdx.x == 0) (void)xb_add(&bar[XB_XCNT(b.x)], 1u);
  return b;
}
DI void xcd_barrier_complete(unsigned* bar, unsigned x, unsigned& nloc, unsigned& nx) {
  const unsigned G = gridDim.x * gridDim.y * gridDim.z;
  unsigned sum, cnt, mine, sp = 0u;
  for (;;) {
    sum = 0u; cnt = 0u; mine = 0u;
#pragma unroll
    for (unsigned j = 0; j < 16; ++j) { const unsigned c = xb_ld(&bar[XB_XCNT(j)]); sum += c; cnt += (c > 0u) ? 1u : 0u; mine = (j == x) ? c : mine; }
    if (sum == G) break;
    __builtin_amdgcn_s_sleep(1);
    if ((++sp & 255u) == 0u) { if (xb_ld(&bar[XB_TMO])) break; if (sp > XB_SPIN_CAP) { atomicAdd(&bar[XB_TMO], 1u); break; } }
  }
  nloc = mine > 0u ? mine : 1u; nx = cnt > 0u ? cnt : 1u;
}
DI void xcd_barrier(const XcdBarrier& b) {
  asm volatile("s_waitcnt vmcnt(0)" ::: "memory");
  __syncthreads();
  if (threadIdx.x == 0) {
    unsigned* bar = b.bar;
    __builtin_amdgcn_s_waitcnt(0);
    unsigned nloc = b.st[0], nx = b.st[1];
    if (nloc == 0u) { xcd_barrier_complete(bar, b.x, nloc, nx); b.st[0] = nloc; b.st[1] = nx; }
    const unsigned old = xb_add(&bar[XB_XSUB(b.x)], 1u);
    const unsigned gen = old / nloc;
    if (old + 1u == (gen + 1u) * nloc) {
      __builtin_amdgcn_fence(__ATOMIC_RELEASE, "agent");
      asm volatile("s_waitcnt vmcnt(0)" ::: "memory");
      const unsigned og = xb_add(&bar[XB_TOP], 1u);
      const unsigned tg = og / nx;
      if (og + 1u == (tg + 1u) * nx) xb_add(&bar[XB_TOPGEN], 1u);
      else XB_SPIN(xb_ld(&bar[XB_TOPGEN]) == tg, bar);
      __builtin_amdgcn_fence(__ATOMIC_ACQUIRE, "agent");
      xb_add(&bar[XB_XGEN(b.x)], 1u);
      asm volatile("s_waitcnt vmcnt(0)" ::: "memory");
    } else {
      XB_SPIN(xb_ld(&bar[XB_XGEN(b.x)]) == gen, bar);
      __builtin_amdgcn_fence(__ATOMIC_ACQUIRE, "agent");
      asm volatile("s_waitcnt vmcnt(0)" ::: "memory");
    }
  }
  __syncthreads();
}

__shared__ int s_vb;
__shared__ uint4 xb_words;
__global__ void __launch_bounds__(256, 2) fwd_megakernel(Params p) {
  __shared__ __attribute__((aligned(16))) char smem[SMEM_BYTES];
  if (p.bar == nullptr) cg::this_grid().sync();
  if (threadIdx.x == 0) xb_words = make_uint4(0u, 0u, 0u, 0u);
  __syncthreads();
  XcdBarrier xb = xcd_barrier_post(p.bar, (volatile LAS unsigned*)&xb_words);
  int xloc = 0;
  if (threadIdx.x == 0) xloc = atomicAdd(p.ctr + 16 + (int)(xb.x & 7u), 1);
  run_phase<0>(p, smem, blockIdx.x); xcd_barrier(xb);
#if defined(REP_PHASE) && REP_PHASE == 0
  run_phase<0>(p, smem, blockIdx.x); xcd_barrier(xb);
#endif
  if (threadIdx.x == 0) {
    bool even = (gridDim.x & 7) == 0;
    for (int i = 0; i < 8; ++i) even = even && (__hip_atomic_load(p.ctr + 16 + i, __ATOMIC_RELAXED, __HIP_MEMORY_SCOPE_AGENT) == (int)(gridDim.x >> 3));
    s_vb = even ? xloc * 8 + (int)(xb.x & 7u) : (int)blockIdx.x;
  }
  __syncthreads();
  const int vb = s_vb;
  run_phase<1>(p, smem, vb); xcd_barrier(xb);
#if defined(REP_PHASE) && REP_PHASE == 1
  run_phase<1>(p, smem, vb, 8); xcd_barrier(xb);
#endif
  run_phase<2>(p, smem, vb); xcd_barrier(xb);
#if defined(REP_PHASE) && REP_PHASE == 2
  run_phase<2>(p, smem, vb, 8); xcd_barrier(xb);
#endif
  run_phase<3>(p, smem, vb); xcd_barrier(xb);
#if defined(REP_PHASE) && REP_PHASE == 3
  run_phase<3>(p, smem, vb, 8); xcd_barrier(xb);
#endif
  run_phase<4>(p, smem, vb); xcd_barrier(xb);
#if defined(REP_PHASE) && REP_PHASE == 4
  run_phase<4>(p, smem, vb, 8); xcd_barrier(xb);
#endif
  run_phase<5>(p, smem, vb); xcd_barrier(xb);
#if defined(REP_PHASE) && REP_PHASE == 5
  run_phase<5>(p, smem, vb, 8); xcd_barrier(xb);
#endif
  run_phase<6>(p, smem, vb); xcd_barrier(xb);
#if defined(REP_PHASE) && REP_PHASE == 6
  run_phase<6>(p, smem, vb, 8); xcd_barrier(xb);
#endif
  run_phase<7>(p, smem, vb); xcd_barrier(xb);
#if defined(REP_PHASE) && REP_PHASE == 7
  run_phase<7>(p, smem, vb, 8); xcd_barrier(xb);
#endif
  run_phase<8>(p, smem, vb); xcd_barrier(xb);
#if defined(REP_PHASE) && REP_PHASE == 8
  run_phase<8>(p, smem, vb, 8); xcd_barrier(xb);
#endif
  run_phase<9>(p, smem, vb);
}

extern "C" void kernel_launch(void* const* d_in, const int* in_sizes, int n_in, void* d_out, int out_size, void* d_ws, size_t ws_size, hipStream_t stream) {
  static int grid_blocks = 0;
  if (!grid_blocks) {
    int dev = 0, cus = 0, per_cu = 0;
    (void)hipGetDevice(&dev);
    (void)hipDeviceGetAttribute(&cus, hipDeviceAttributeMultiprocessorCount, dev);
    (void)hipOccupancyMaxActiveBlocksPerMultiprocessor(&per_cu, fwd_megakernel, 256, 0);
    if (per_cu < 1) per_cu = 1;
    if (per_cu > 2) per_cu = 2;
    grid_blocks = cus * per_cu;
  }
  Params p{};
  const float* const* in = (const float* const*)d_in;
  p.x_prompt = in[0]; p.x_sample = in[1]; p.st_s5_re = in[2]; p.st_s5_im = in[3]; p.st_gdn = in[4]; p.st_gdn_conv = in[5]; p.st_ffn_conv = in[6];
  p.norm1_g = in[7]; p.w_in = in[8]; p.a_re = in[9]; p.a_im = in[10]; p.log_dt = in[11]; p.b_re = in[12]; p.b_im = in[13]; p.c_re = in[14]; p.c_im = in[15];
  p.s5_d = in[16]; p.w_glu = in[17]; p.gdn_conv_w = in[18]; p.a_log = in[19]; p.dt_bias = in[20]; p.onorm_g = in[21]; p.w_out = in[22]; p.norm2_g = in[23];
  p.w_up = in[24]; p.ffn_conv_w = in[25]; p.w_down = in[26]; p.normf_g = in[27];
  float* o = (float*)d_out;
  p.out = o;
  size_t off = (size_t)MROWS * 1024;
  p.p_s5_re = o + off; off += 8 * 32 * 64;
  p.p_s5_im = o + off; off += 8 * 32 * 64;
  p.p_gdn = o + off; off += (size_t)8 * 4 * 128 * 128;
  p.p_gdn_conv = o + off; off += 8 * 3 * 1536;
  p.p_ffn_conv = o + off; off += 8 * 2 * 5632;
  p.s_s5_re = o + off; off += 128 * 32 * 64;
  p.s_s5_im = o + off; off += 128 * 32 * 64;
  p.s_gdn = o + off; off += (size_t)128 * 4 * 128 * 128;
  p.s_gdn_conv = o + off; off += 128 * 3 * 1536;
  p.s_ffn_conv = o + off; off += 128 * 2 * 5632;
  p.ogdn = o;
  p.ys5 = (bf16_t*)(o + (size_t)NTOK * 512);
  char* ws = (char*)d_ws;
  size_t wo = 0;
  auto take = [&](size_t bytes) { char* r = ws + wo; wo += (bytes + 255) & ~(size_t)255; return r; };
  p.ctr = (int*)take(256);
  p.bar = (unsigned*)take(XCD_BAR_WORDS * 4);
  p.ba = (float*)take((size_t)MROWS * 8 * 4);
  p.glast = (float*)take(1024 * 4);
  p.sproj = (float*)take((size_t)128 * NPROJ * 4);
  p.WinT = (bf16_t*)take((size_t)2560 * 1024 * 2);
  p.WgluT = (bf16_t*)take((size_t)1024 * 512 * 2);
  p.WoutT = (bf16_t*)take((size_t)1024 * 1024 * 2);
  p.WupT = (bf16_t*)take((size_t)5632 * 1024 * 2);
  p.WdnT = (bf16_t*)take((size_t)1024 * 2816 * 2);
  p.XN = (bf16_t*)take((size_t)MROWS * 1024 * 2);
  p.PROJ = (bf16_t*)take((size_t)MROWS * NPROJ * 2);
  p.ACT = p.PROJ;
  p.GDNI = (bf16_t*)take((size_t)1024 * 36864 * 2);
  if (wo > ws_size) { fprintf(stderr, "workspace too small: need %zu have %zu\n", wo, ws_size); return; }
  (void)hipMemsetAsync(p.ctr, 0, 256 + ((XCD_BAR_WORDS * 4 + 255) & ~255), stream);
#if MK_MULTI
  phase_kernel<0><<<grid_blocks, 256, 0, stream>>>(p);
  phase_kernel<1><<<grid_blocks, 256, 0, stream>>>(p);
  phase_kernel<2><<<grid_blocks, 256, 0, stream>>>(p);
  phase_kernel<3><<<grid_blocks, 256, 0, stream>>>(p);
  phase_kernel<4><<<grid_blocks, 256, 0, stream>>>(p);
  phase_kernel<5><<<grid_blocks, 256, 0, stream>>>(p);
  phase_kernel<6><<<grid_blocks, 256, 0, stream>>>(p);
  phase_kernel<7><<<grid_blocks, 256, 0, stream>>>(p);
  phase_kernel<8><<<grid_blocks, 256, 0, stream>>>(p);
  phase_kernel<9><<<grid_blocks, 256, 0, stream>>>(p);
#else
  void* args[] = {&p};
  hipError_t e = hipLaunchCooperativeKernel((void*)fwd_megakernel, dim3(grid_blocks), dim3(256), args, 0, stream);
  if (e != hipSuccess) fprintf(stderr, "cooperative launch failed: %s (grid %d)\n", hipGetErrorString(e), grid_blocks);
#endif
}
```

```cpp
#include <hip/hip_runtime.h>
#include <hip/hip_cooperative_groups.h>
#include <cstdio>
namespace cg = cooperative_groups;

#ifndef MK_MULTI
#define MK_MULTI 0
#endif

typedef unsigned short bf16_t;
using bf16x8 = __attribute__((ext_vector_type(8))) short;
using f32x4 = __attribute__((ext_vector_type(4))) float;
using u32x4 = __attribute__((ext_vector_type(4))) unsigned;

#define DI __device__ __forceinline__

typedef __bf16 bf16x2_t __attribute__((ext_vector_type(2)));
typedef float f32x2_t __attribute__((ext_vector_type(2)));
DI bf16_t f2bf(float x) { __bf16 h = (__bf16)x; return __builtin_bit_cast(bf16_t, h); }
DI float bf2f(bf16_t b) { return __uint_as_float(((unsigned)b) << 16); }
DI unsigned pack2(float a, float b) { f32x2_t v = {a, b}; bf16x2_t r = __builtin_convertvector(v, bf16x2_t); return __builtin_bit_cast(unsigned, r); }
DI float bflo(unsigned u) { return __uint_as_float(u << 16); }
DI float bfhi(unsigned u) { return __uint_as_float(u & 0xffff0000u); }
DI float sigmoidf_(float x) { return 1.f / (1.f + __expf(-x)); }
DI float siluf_(float x) { return x / (1.f + __expf(-x)); }
DI float geluf_(float x) { float u = 0.7978845608028654f * (x + 0.044715f * x * x * x); float th = 1.f - 2.f / (1.f + __expf(2.f * u)); return 0.5f * x * (1.f + th); }
DI float wave_sum(float v) { for (int o = 32; o > 0; o >>= 1) v += __shfl_xor(v, o); return v; }
DI f32x4 mfma16(bf16x8 a, bf16x8 b, f32x4 c) { return __builtin_amdgcn_mfma_f32_16x16x32_bf16(a, b, c, 0, 0, 0); }

constexpr int NTOK = 16384;
constexpr int MROWS = 16512;
constexpr int NPROJ = 2560;
constexpr int SMEM_BYTES = 67584;

struct Params {
  const float *x_prompt, *x_sample, *st_s5_re, *st_s5_im, *st_gdn, *st_gdn_conv, *st_ffn_conv;
  const float *norm1_g, *w_in, *a_re, *a_im, *log_dt, *b_re, *b_im, *c_re, *c_im, *s5_d, *w_glu;
  const float *gdn_conv_w, *a_log, *dt_bias, *onorm_g, *w_out, *norm2_g, *w_up, *ffn_conv_w, *w_down, *normf_g;
  float *out;
  float *p_s5_re, *p_s5_im, *p_gdn, *p_gdn_conv, *p_ffn_conv, *s_s5_re, *s_s5_im, *s_gdn, *s_gdn_conv, *s_ffn_conv;
  float *ogdn;
  bf16_t *ys5;
  int *ctr; unsigned *bar; float *ba; float *glast; float *sproj;
  bf16_t *WinT, *WgluT, *WoutT, *WupT, *WdnT, *XN, *PROJ, *GDNI, *ACT;
};

DI const float* xin_row(const Params& p, int row) {
  return row < NTOK ? p.x_prompt + (size_t)row * 1024 : p.x_sample + (size_t)(row - NTOK) * 1024;
}

__shared__ int s_item;
DI int fetch_item(int* ctr) {
  __syncthreads();
  if (threadIdx.x == 0) s_item = atomicAdd(ctr, 1);
  __syncthreads();
  return s_item;
}

DI void lds_barrier() { asm volatile("s_waitcnt lgkmcnt(0)\n\ts_barrier" ::: "memory"); }

DI float block_sum(float v, float* red) {
  v = wave_sum(v);
  __syncthreads();
  if ((threadIdx.x & 63) == 0) red[threadIdx.x >> 6] = v;
  __syncthreads();
  return red[0] + red[1] + red[2] + red[3];
}

DI void transpose_item(const float* src, int ldsrc, int srccol0, int k0, bf16_t* dst, int lddst, int r0, float* tl) {
  const int t = threadIdx.x;
  float v[4][8];
  { const int jj = t & 31, kk = t >> 5;
#pragma unroll
    for (int kb = 0; kb < 4; ++kb)
#pragma unroll
      for (int i = 0; i < 8; ++i) v[kb][i] = src[(size_t)(k0 + kb * 64 + kk + 8 * i) * ldsrc + srccol0 + jj]; }
#pragma unroll
  for (int kb = 0; kb < 4; ++kb) {
    { const int jj = t & 31, kk = t >> 5;
#pragma unroll
      for (int i = 0; i < 8; ++i) tl[(kk + 8 * i) * 33 + jj] = v[kb][i]; }
    __syncthreads();
    { const int kk = t & 63, jj = t >> 6;
#pragma unroll
      for (int i = 0; i < 8; ++i) dst[(size_t)(r0 + jj + 4 * i) * lddst + k0 + kb * 64 + kk] = f2bf(tl[kk * 33 + jj + 4 * i]); }
    __syncthreads();
  }
}

DI int perm_col(int r0, int halfoff) {
  const int tt = r0 >> 7, rr = r0 & 127, wn = rr >> 6, half = (rr >> 5) & 1;
  return half * halfoff + tt * 64 + wn * 32;
}

__device__ void phase0(const Params& p, char* smem) {
  float* wt = (float*)smem;
  float* tl = (float*)(smem + 32768);
  for (int i = threadIdx.x; i < 8192; i += 256) { const int k = i >> 3, j = i & 7; wt[j * 1024 + k] = p.w_in[(size_t)k * 2568 + 2560 + j]; }
  __syncthreads();
  for (int i = blockIdx.x * 256 + threadIdx.x; i < 128 * NPROJ / 4; i += gridDim.x * 256) *(float4*)(p.sproj + (size_t)i * 4) = make_float4(0.f, 0.f, 0.f, 0.f);
  constexpr int NT_IN = 320, NT_GLU = 64, NT_OUT = 128, NT_UP = 704, NT_DN = 352;
  constexpr int nT = NT_IN + NT_GLU + NT_OUT + NT_UP + NT_DN;
  constexpr int nRow = MROWS / 8;
  for (int it = blockIdx.x; it < nT + nRow; it += gridDim.x) {
    if (it < nT) {
      int i = it;
      if (i < NT_IN) { const int r0 = (i >> 2) * 32, k0 = (i & 3) * 256; transpose_item(p.w_in, 2568, r0, k0, p.WinT, 1024, r0, tl); continue; }
      i -= NT_IN;
      if (i < NT_GLU) { const int r0 = (i >> 1) * 32, k0 = (i & 1) * 256; transpose_item(p.w_glu, 1024, perm_col(r0, 512), k0, p.WgluT, 512, r0, tl); continue; }
      i -= NT_GLU;
      if (i < NT_OUT) { const int r0 = (i >> 2) * 32, k0 = (i & 3) * 256; transpose_item(p.w_out, 1024, r0, k0, p.WoutT, 1024, r0, tl); continue; }
      i -= NT_OUT;
      if (i < NT_UP) { const int r0 = (i >> 2) * 32, k0 = (i & 3) * 256; transpose_item(p.w_up, 5632, perm_col(r0, 2816), k0, p.WupT, 1024, r0, tl); continue; }
      i -= NT_UP;
      { const int r0 = (i / 11) * 32, k0 = (i % 11) * 256; transpose_item(p.w_down, 1024, r0, k0, p.WdnT, 2816, r0, tl); }
    } else {
      const int lane = threadIdx.x & 63, w = threadIdx.x >> 6;
      float4 v2[2][4];
#pragma unroll
      for (int rr = 0; rr < 2; ++rr) {
        const float* xr = xin_row(p, (it - nT) * 8 + rr * 4 + w);
#pragma unroll
        for (int i = 0; i < 4; ++i) v2[rr][i] = *(const float4*)(xr + i * 256 + lane * 4);
      }
#pragma unroll
      for (int rr = 0; rr < 2; ++rr) {
        const int row = (it - nT) * 8 + rr * 4 + w;
        float4 v[4]; float ss = 0.f;
#pragma unroll
        for (int i = 0; i < 4; ++i) { v[i] = v2[rr][i]; ss += v[i].x * v[i].x + v[i].y * v[i].y + v[i].z * v[i].z + v[i].w * v[i].w; }
        ss = wave_sum(ss);
        const float rstd = rsqrtf(ss * (1.f / 1024.f) + 1e-6f);
        float acc[8];
#pragma unroll
        for (int j = 0; j < 8; ++j) acc[j] = 0.f;
#pragma unroll
        for (int i = 0; i < 4; ++i) {
          const float4 g = *(const float4*)(p.norm1_g + i * 256 + lane * 4);
          v[i].x *= rstd * g.x; v[i].y *= rstd * g.y; v[i].z *= rstd * g.z; v[i].w *= rstd * g.w;
          uint2 pk; pk.x = pack2(v[i].x, v[i].y); pk.y = pack2(v[i].z, v[i].w);
          *(uint2*)(p.XN + (size_t)row * 1024 + i * 256 + lane * 4) = pk;
#pragma unroll
          for (int j = 0; j < 8; ++j) { const float4 wv = *(const float4*)(wt + j * 1024 + i * 256 + lane * 4); acc[j] += v[i].x * wv.x + v[i].y * wv.y + v[i].z * wv.z + v[i].w * wv.w; }
        }
#pragma unroll
        for (int j = 0; j < 8; ++j) acc[j] = wave_sum(acc[j]);
        if (lane == 0) {
          *(float4*)(p.ba + (size_t)row * 8) = make_float4(acc[0], acc[1], acc[2], acc[3]);
          *(float4*)(p.ba + (size_t)row * 8 + 4) = make_float4(acc[4], acc[5], acc[6], acc[7]);
        }
      }
    }
  }
}

template <bool NULLCHK, int PMODE = 0>
DI void gemm_main(const bf16_t* a0, size_t astr, unsigned amask, const bf16_t* b0, size_t bstr, int nk, f32x4 (&acc)[4][4], char* smem) {
  char* As = smem;
  char* Bs = smem + 16384;
  const int t = threadIdx.x, lane = t & 63, w = t >> 6, wm = w >> 1, wn = w & 1, r = lane & 15, q = lane >> 4;
  const u32x4 z4 = u32x4{0u, 0u, 0u, 0u};
  u32x4 ra0[4], rb0[4];
  const int soff = (t >> 3) * 128 + (((t & 7) ^ ((t >> 3) & 7)) * 16);
  const int aoff = (wm * 64 + r) * 128, boff = (wn * 64 + r) * 128;
  const int sw0 = ((q) ^ (r & 7)) * 16, sw1 = ((4 + q) ^ (r & 7)) * 16;
#define G_LOAD(RA, RB, KT) _Pragma("unroll") for (int i = 0; i < 4; ++i) { \
    RA[i] = (!NULLCHK || ((amask >> i) & 1u)) ? *(const u32x4*)(a0 + i * astr + (KT) * 64) : z4; \
    RB[i] = *(const u32x4*)(b0 + i * bstr + (KT) * 64); }
#define G_STORE(RA, RB) _Pragma("unroll") for (int i = 0; i < 4; ++i) { \
    *(u32x4*)(As + soff + i * 4096) = RA[i]; \
    *(u32x4*)(Bs + soff + i * 4096) = RB[i]; }
#define G_COMPUTE() _Pragma("unroll") for (int ks = 0; ks < 2; ++ks) { \
    bf16x8 af[4], bfr[4]; \
    _Pragma("unroll") for (int mi = 0; mi < 4; ++mi) af[mi] = *(const bf16x8*)(As + aoff + mi * 2048 + (ks ? sw1 : sw0)); \
    _Pragma("unroll") for (int ni = 0; ni < 4; ++ni) bfr[ni] = *(const bf16x8*)(Bs + boff + ni * 2048 + (ks ? sw1 : sw0)); \
    __builtin_amdgcn_s_setprio(1); \
    _Pragma("unroll") for (int mi = 0; mi < 4; ++mi) _Pragma("unroll") for (int ni = 0; ni < 4; ++ni) acc[mi][ni] = mfma16(bfr[ni], af[mi], acc[mi][ni]); \
    __builtin_amdgcn_s_setprio(0); }
  G_LOAD(ra0, rb0, 0)
#pragma unroll
  for (int mi = 0; mi < 4; ++mi)
#pragma unroll
    for (int ni = 0; ni < 4; ++ni) acc[mi][ni] = f32x4{0.f, 0.f, 0.f, 0.f};
  for (int kt = 0; kt < nk; ++kt) {
    if (kt == 0) __syncthreads(); else lds_barrier();
    G_STORE(ra0, rb0)
    asm volatile("s_waitcnt lgkmcnt(0)" ::: "memory");
    __builtin_amdgcn_sched_barrier(0);
    if (PMODE != 1 && kt + 1 < nk) { G_LOAD(ra0, rb0, kt + 1) }
    __builtin_amdgcn_sched_barrier(0);
    asm volatile("s_barrier" ::: "memory");
    __builtin_amdgcn_sched_barrier(0);
    G_COMPUTE()
  }
#undef G_LOAD
#undef G_STORE
#undef G_COMPUTE
}

template <int PMODE = 0>
DI void gemm_std(const bf16_t* A, int lda, int m0, const bf16_t* Bt, int ldb, int n0, int nk, f32x4 (&acc)[4][4], char* smem) {
  const int t = threadIdx.x;
  const bf16_t* a0 = A + (size_t)(m0 + (t >> 3)) * lda + (t & 7) * 8;
  const bf16_t* b0 = Bt + (size_t)(n0 + (t >> 3)) * ldb + (t & 7) * 8;
  gemm_main<false, PMODE>(a0, (size_t)32 * lda, 0xfu, b0, (size_t)32 * ldb, nk, acc, smem);
}

DI bool get_tile(int vb, int step, int MT, int NT, int GW, int& mt, int& nt, bool& valid) {
  const int G = gridDim.x;
  if ((G & 7) == 0 && ((G >> 3) % GW) == 0) {
    const int xcd = vb & 7, local = vb >> 3, GH = (G >> 3) / GW;
    const int NGN = (NT + GW - 1) / GW, NGM = (MT + GH - 1) / GH;
    const int g = step * 8 + xcd;
    if (g >= NGN * NGM) return false;
    mt = (g / NGN) * GH + local / GW; nt = (g % NGN) * GW + local % GW;
    valid = mt < MT && nt < NT;
    return true;
  }
  const int idx = vb + step * G;
  if (idx >= MT * NT) return false;
  mt = idx / NT; nt = idx % NT; valid = true;
  return true;
}

DI bool get_tile_strip(int vb, int step, int MT, int NT, int GW, int& mt, int& nt) {
  const int G = gridDim.x, T = MT * NT;
  int idx;
  if ((G & 7) == 0) {
    const int xcd = vb & 7, local = vb >> 3, lpx = G >> 3;
    const int start = (int)(((long)T * xcd) >> 3), end = (int)(((long)T * (xcd + 1)) >> 3);
    idx = start + local + lpx * step;
    if (idx >= end) return false;
  } else {
    idx = vb + step * G;
    if (idx >= T) return false;
  }
  const int strip = idx / (MT * GW), rem = idx % (MT * GW);
  mt = rem / GW; nt = strip * GW + rem % GW;
  return true;
}

#define EPI_COORDS const int t = threadIdx.x, lane = t & 63, w = t >> 6, wm = w >> 1, wn = w & 1, r = lane & 15, q = lane >> 4; (void)wm; (void)wn; (void)r; (void)q;

DI void sample_splitk_task(float* obase, int ldo, const bf16_t* A, int lda, const bf16_t* Bt, int ldb, int nt, int ks, char* smem) {
  f32x4 acc[4][4];
  gemm_std(A + (size_t)ks * 256, lda, NTOK, Bt + (size_t)ks * 256, ldb, nt * 128, 4, acc, smem);
  EPI_COORDS
#pragma unroll
  for (int mi = 0; mi < 4; ++mi)
#pragma unroll
    for (int ni = 0; ni < 4; ++ni) {
      float* o = obase + (size_t)(wm * 64 + mi * 16 + r) * ldo + nt * 128 + wn * 64 + ni * 16 + q * 4;
#pragma unroll
      for (int j = 0; j < 4; ++j) unsafeAtomicAdd(o + j, acc[mi][ni][j]);
    }
}

#ifndef REP_MODE
#define REP_MODE 0
#endif
template <int PMODE>
DI void phase1(const Params& p, char* smem, int vb) {
  constexpr int NT = 20, MT = 128;
  if (PMODE == 0 && vb < 80) sample_splitk_task(p.sproj, NPROJ, p.XN, 1024, p.WinT, 1024, vb % 20, vb / 20, smem);
  for (int step = 0;; ++step) {
    int mt, nt;
    if (!get_tile_strip(vb, step, MT, NT, 4, mt, nt)) break;
    f32x4 acc[4][4];
    if (PMODE == 2) gemm_std<0>(p.XN, 1024, 0, p.WinT, 1024, 0, 16, acc, smem);
    else gemm_std<PMODE>(p.XN, 1024, mt * 128, p.WinT, 1024, nt * 128, 16, acc, smem);
    if (PMODE != 0 && p.ctr[40] == 0) continue;
    EPI_COORDS
#pragma unroll
    for (int mi = 0; mi < 4; ++mi)
#pragma unroll
      for (int ni = 0; ni < 4; ++ni) {
        const int row = mt * 128 + wm * 64 + mi * 16 + r, col = nt * 128 + wn * 64 + ni * 16 + q * 4;
        uint2 pk; pk.x = pack2(acc[mi][ni][0], acc[mi][ni][1]); pk.y = pack2(acc[mi][ni][2], acc[mi][ni][3]);
        *(uint2*)(p.PROJ + (size_t)row * NPROJ + col) = pk;
      }
  }
}

DI void s5_disc(const Params& p, int g, int n, float& abr, float& abi, float& fre, float& fim) {
  const float ar = p.a_re[g * 64 + n], ai = p.a_im[g * 64 + n], dt = expf(p.log_dt[g]);
  const float mag = expf(ar * dt);
  float sn, cs; sincosf(ai * dt, &sn, &cs);
  abr = mag * cs; abi = mag * sn;
  const float den = ar * ar + ai * ai, pp = abr - 1.f;
  fre = (pp * ar + abi * ai) / den; fim = (abi * ar - pp * ai) / den;
}

__device__ void s5_scan_item(const Params& p, int item, char* smem) {
  const int b = item >> 5, g = item & 31;
  float* Xs = (float*)smem;
  bf16_t* Hs = (bf16_t*)(smem + 32768);
  bf16_t* Us = (bf16_t*)(smem + 32768 + 17408);
  const int t = threadIdx.x, lane = t & 63, w = t >> 6, r = lane & 15, q = lane >> 4;
  for (int i = t; i < 64 * 40; i += 256) Us[i] = 0;
  bf16x8 bfrag[2];
#pragma unroll
  for (int x = 0; x < 2; ++x) {
    const int np = (2 * w + x) * 16 + r, n = np >> 1, part = np & 1;
    float abr, abi, fre, fim; s5_disc(p, g, n, abr, abi, fre, fim);
#pragma unroll
    for (int jj = 0; jj < 8; ++jj) {
      float val = 0.f;
      if (q < 2) {
        const int c = q * 8 + jj;
        const float br = p.b_re[(size_t)(g * 64 + n) * 16 + c], bi = p.b_im[(size_t)(g * 64 + n) * 16 + c];
        val = part == 0 ? fre * br - fim * bi : fre * bi + fim * br;
      }
      bfrag[x][jj] = (short)f2bf(val);
    }
  }
  bf16x8 cfrag[4];
#pragma unroll
  for (int ks = 0; ks < 4; ++ks)
#pragma unroll
    for (int jj = 0; jj < 8; ++jj) {
      const int k = ks * 32 + q * 8 + jj;
      const float val = (k & 1) == 0 ? p.c_re[(size_t)(g * 16 + r) * 64 + (k >> 1)] : -p.c_im[(size_t)(g * 16 + r) * 64 + (k >> 1)];
      cfrag[ks][jj] = (short)f2bf(val);
    }
  float abr, abi, hr = 0.f, hi = 0.f;
  { float fre, fim; s5_disc(p, g, lane, abr, abi, fre, fim); }
  const float4 dco = *(const float4*)(p.s5_d + g * 16 + q * 4);
  __syncthreads();
  u32x4 unext = u32x4{0u, 0u, 0u, 0u};
  if (t < 128) unext = *(const u32x4*)(p.PROJ + ((size_t)b * 2048 + (t >> 1)) * NPROJ + g * 16 + (t & 1) * 8);
  for (int ch = 0; ch < 32; ++ch) {
    const size_t tok0 = (size_t)b * 2048 + ch * 64;
    if (t < 128) {
      *(u32x4*)(Us + (t >> 1) * 40 + (t & 1) * 8) = unext;
      if (ch + 1 < 32) unext = *(const u32x4*)(p.PROJ + (tok0 + 64 + (t >> 1)) * NPROJ + g * 16 + (t & 1) * 8);
    }
    lds_barrier();
    {
      bf16x8 af[4];
#pragma unroll
      for (int mt = 0; mt < 4; ++mt) af[mt] = *(const bf16x8*)(Us + (mt * 16 + r) * 40 + q * 8);
#pragma unroll
      for (int x = 0; x < 2; ++x)
#pragma unroll
        for (int mt = 0; mt < 4; ++mt) {
          f32x4 z = f32x4{0.f, 0.f, 0.f, 0.f};
          z = mfma16(af[mt], bfrag[x], z);
          const int col = (2 * w + x) * 16 + r;
#pragma unroll
          for (int j = 0; j < 4; ++j) Xs[(mt * 16 + q * 4 + j) * 128 + col] = z[j];
        }
    }
    lds_barrier();
    if (w == 0) {
      for (int tb = 0; tb < 8; ++tb) {
        f32x2_t xv[8];
#pragma unroll
        for (int u = 0; u < 8; ++u) xv[u] = *(const f32x2_t*)(Xs + (tb * 8 + u) * 128 + 2 * lane);
#pragma unroll
        for (int u = 0; u < 8; ++u) {
          const float nr = abr * hr - abi * hi + xv[u][0], ni = abr * hi + abi * hr + xv[u][1];
          hr = nr; hi = ni;
          *(unsigned*)(Hs + (tb * 8 + u) * 136 + 2 * lane) = pack2(hr, hi);
        }
      }
    }
    lds_barrier();
    {
      f32x4 y = f32x4{0.f, 0.f, 0.f, 0.f};
#pragma unroll
      for (int ks = 0; ks < 4; ++ks) { const bf16x8 a = *(const bf16x8*)(Hs + (w * 16 + r) * 136 + ks * 32 + q * 8); y = mfma16(cfrag[ks], a, y); }
      const int tk = w * 16 + r;
      const uint2 ur = *(const uint2*)(Us + tk * 40 + q * 4);
      const float o0 = geluf_(y[0] + dco.x * bflo(ur.x)), o1 = geluf_(y[1] + dco.y * bfhi(ur.x));
      const float o2 = geluf_(y[2] + dco.z * bflo(ur.y)), o3 = geluf_(y[3] + dco.w * bfhi(ur.y));
      uint2 pk; pk.x = pack2(o0, o1); pk.y = pack2(o2, o3);
      *(uint2*)(p.ys5 + (tok0 + tk) * 512 + g * 16 + q * 4) = pk;
    }
    lds_barrier();
  }
  if (w == 0) { p.p_s5_re[(size_t)(b * 32 + g) * 64 + lane] = hr; p.p_s5_im[(size_t)(b * 32 + g) * 64 + lane] = hi; }
}

__device__ void s5_decode_item(const Params& p, int s, char* smem) {
  float* us = (float*)smem; float* hre = us + 512; float* him = hre + 2048;
  const int t = threadIdx.x; const size_t row = NTOK + s;
  __syncthreads();
  for (int i = t; i < 512; i += 256) us[i] = p.sproj[(size_t)s * NPROJ + i];
  __syncthreads();
  for (int gq = 0; gq < 8; ++gq) {
    const int g = gq * 4 + (t >> 6), n = t & 63;
    float abr, abi, fre, fim; s5_disc(p, g, n, abr, abi, fre, fim);
    const float* br = p.b_re + (size_t)(g * 64 + n) * 16; const float* bi = p.b_im + (size_t)(g * 64 + n) * 16;
    float bur = 0.f, bui = 0.f;
#pragma unroll
    for (int c = 0; c < 16; ++c) { const float u = us[g * 16 + c]; bur += br[c] * u; bui += bi[c] * u; }
    const float xr = fre * bur - fim * bui, xi = fre * bui + fim * bur;
    const size_t si = (size_t)(s * 32 + g) * 64 + n;
    const float h0r = p.st_s5_re[si], h0i = p.st_s5_im[si];
    const float hr = abr * h0r - abi * h0i + xr, hi = abr * h0i + abi * h0r + xi;
    p.s_s5_re[si] = hr; p.s_s5_im[si] = hi;
    hre[g * 64 + n] = hr; him[g * 64 + n] = hi;
  }
  __syncthreads();
  for (int o = t; o < 512; o += 256) {
    const int g = o >> 4;
    const float* cr = p.c_re + (size_t)o * 64; const float* ci = p.c_im + (size_t)o * 64;
    float y = 0.f;
    for (int n = 0; n < 64; ++n) y += cr[n] * hre[g * 64 + n] - ci[n] * him[g * 64 + n];
    y += p.s5_d[o] * us[o];
    p.ys5[row * 512 + o] = f2bf(geluf_(y));
  }
  __syncthreads();
}

__device__ void gdn_prep_item(const Params& p, int item, char* smem) {
  const int c = item & 31, h = (item >> 5) & 3, b = item >> 7;
  bf16_t* Kn = (bf16_t*)smem;
  bf16_t* Qn = (bf16_t*)(smem + 16384);
  float* Lm = (float*)(smem + 16384);
  bf16_t* Vs = (bf16_t*)(smem + 32768);
  float* gcs = (float*)(smem + 49152);
  float* bts = gcs + 64;
  float* egs = bts + 64;
  const int t = threadIdx.x, lane = t & 63, w = t >> 6, r = lane & 15, q = lane >> 4;
  const int tok0 = c * 64; const size_t row0 = (size_t)b * 2048 + tok0;
  bf16_t* gi = p.GDNI + (size_t)item * 36864;
  __syncthreads();
  if (w == 0) {
    const float* bar = p.ba + (row0 + lane) * 8;
    const float beta = sigmoidf_(bar[h]);
    const float xx = bar[4 + h] + p.dt_bias[h];
    const float sp = fmaxf(xx, 0.f) + log1pf(expf(-fabsf(xx)));
    float s = -expf(p.a_log[h]) * sp;
    for (int o = 1; o < 64; o <<= 1) { const float y = __shfl_up(s, o); if (lane >= o) s += y; }
    gcs[lane] = s; bts[lane] = beta; egs[lane] = expf(s);
  }
  __syncthreads();
  if (c == 31) {
    for (int idx = t; idx < 1152; idx += 256) {
      const int i = idx / 384, rem = idx % 384, X = rem >> 7, cc = rem & 127;
      const int col = X * 512 + h * 128 + cc;
      p.p_gdn_conv[(size_t)(b * 3 + i) * 1536 + col] = bf2f(p.PROJ[((size_t)b * 2048 + 2045 + i) * NPROJ + 512 + col]);
    }
  }
  {
    const int row = t >> 2, seg = t & 3;
    const float eg = egs[row], ekg = expf(gcs[63] - gcs[row]);
    const int tok = tok0 + row;
#pragma unroll
    for (int X = 0; X < 3; ++X) {
      float val[32]; float ss = 0.f;
      const int colbase = X * 512 + h * 128 + seg * 32;
#pragma unroll
      for (int cb = 0; cb < 4; ++cb) {
        float a8[8];
#pragma unroll
        for (int e = 0; e < 8; ++e) a8[e] = 0.f;
#pragma unroll
        for (int tap = 0; tap < 4; ++tap) {
          const int tk = tok - 3 + tap;
          if (tk >= 0) {
            const uint4 raw = *(const uint4*)(p.PROJ + ((size_t)b * 2048 + tk) * NPROJ + 512 + colbase + cb * 8);
            const float* wp = p.gdn_conv_w + tap * 1536 + colbase + cb * 8;
            const float4 w0 = *(const float4*)wp, w1 = *(const float4*)(wp + 4);
            a8[0] += bflo(raw.x) * w0.x; a8[1] += bfhi(raw.x) * w0.y; a8[2] += bflo(raw.y) * w0.z; a8[3] += bfhi(raw.y) * w0.w;
            a8[4] += bflo(raw.z) * w1.x; a8[5] += bfhi(raw.z) * w1.y; a8[6] += bflo(raw.w) * w1.z; a8[7] += bfhi(raw.w) * w1.w;
          }
        }
#pragma unroll
        for (int e = 0; e < 8; ++e) { const float v = siluf_(a8[e]); val[cb * 8 + e] = v; ss += v * v; }
        __builtin_amdgcn_sched_barrier(0);
      }
      if (X < 2) {
        ss += __shfl_xor(ss, 1); ss += __shfl_xor(ss, 2);
        const float sc = rsqrtf(ss + 1e-6f) * (X == 0 ? 0.08838834764831845f : 1.f);
#pragma unroll
        for (int e = 0; e < 32; ++e) val[e] *= sc;
      }
      if (X == 0) {
#pragma unroll
        for (int cb = 0; cb < 4; ++cb) {
          uint4 pk; pk.x = pack2(val[cb * 8], val[cb * 8 + 1]); pk.y = pack2(val[cb * 8 + 2], val[cb * 8 + 3]); pk.z = pack2(val[cb * 8 + 4], val[cb * 8 + 5]); pk.w = pack2(val[cb * 8 + 6], val[cb * 8 + 7]);
          *(uint4*)(Qn + row * 128 + (((seg * 4 + cb) ^ (row & 15)) * 8)) = pk;
          uint4 pg; pg.x = pack2(val[cb * 8] * eg, val[cb * 8 + 1] * eg); pg.y = pack2(val[cb * 8 + 2] * eg, val[cb * 8 + 3] * eg); pg.z = pack2(val[cb * 8 + 4] * eg, val[cb * 8 + 5] * eg); pg.w = pack2(val[cb * 8 + 6] * eg, val[cb * 8 + 7] * eg);
          *(uint4*)(gi + 16384 + row * 128 + seg * 32 + cb * 8) = pg;
        }
      } else if (X == 1) {
#pragma unroll
        for (int cb = 0; cb < 4; ++cb) {
          uint4 pk; pk.x = pack2(val[cb * 8], val[cb * 8 + 1]); pk.y = pack2(val[cb * 8 + 2], val[cb * 8 + 3]); pk.z = pack2(val[cb * 8 + 4], val[cb * 8 + 5]); pk.w = pack2(val[cb * 8 + 6], val[cb * 8 + 7]);
          *(uint4*)(Kn + row * 128 + (((seg * 4 + cb) ^ (row & 15)) * 8)) = pk;
        }
#pragma unroll
        for (int e = 0; e < 32; ++e) gi[24576 + (seg * 32 + e) * 64 + row] = f2bf(val[e] * ekg);
      } else {
#pragma unroll
        for (int cb = 0; cb < 4; ++cb) {
          uint4 pk; pk.x = pack2(val[cb * 8], val[cb * 8 + 1]); pk.y = pack2(val[cb * 8 + 2], val[cb * 8 + 3]); pk.z = pack2(val[cb * 8 + 4], val[cb * 8 + 5]); pk.w = pack2(val[cb * 8 + 6], val[cb * 8 + 7]);
          *(uint4*)(Vs + row * 128 + seg * 32 + cb * 8) = pk;
        }
      }
    }
  }
  __syncthreads();
  f32x4 kk[4], qk[4];
  {
    bf16x8 ak[4], aq[4];
    const int rowA = w * 16 + r;
#pragma unroll
    for (int ks = 0; ks < 4; ++ks) { const int phys = (ks * 4 + q) ^ r; ak[ks] = *(const bf16x8*)(Kn + rowA * 128 + phys * 8); aq[ks] = *(const bf16x8*)(Qn + rowA * 128 + phys * 8); }
#pragma unroll
    for (int nt = 0; nt < 4; ++nt) {
      kk[nt] = f32x4{0.f, 0.f, 0.f, 0.f}; qk[nt] = f32x4{0.f, 0.f, 0.f, 0.f};
      if (nt <= w) {
        const int rowB = nt * 16 + r;
#pragma unroll
        for (int ks = 0; ks < 4; ++ks) {
          const int phys = (ks * 4 + q) ^ r;
          const bf16x8 bb = *(const bf16x8*)(Kn + rowB * 128 + phys * 8);
          kk[nt] = mfma16(ak[ks], bb, kk[nt]); qk[nt] = mfma16(aq[ks], bb, qk[nt]);
        }
      }
    }
  }
  __syncthreads();
#pragma unroll
  for (int nt = 0; nt < 4; ++nt)
#pragma unroll
    for (int j = 0; j < 4; ++j) {
      const int i = w * 16 + q * 4 + j, jc = nt * 16 + r;
      const float dec = __expf(fminf(gcs[i] - gcs[jc], 0.f));
      Lm[i * 64 + jc] = (i > jc) ? bts[i] * kk[nt][j] * dec : 0.f;
      gi[32768 + i * 64 + jc] = f2bf((i >= jc) ? qk[nt][j] * dec : 0.f);
    }
  __syncthreads();
  {
    float sol[64];
    const bool isv = t < 128;
    const int kc = t - 128;
    if (isv) {
#pragma unroll
      for (int i = 0; i < 64; ++i) { sol[i] = bf2f(Vs[i * 128 + t]) * bts[i]; if ((i & 7) == 7) __builtin_amdgcn_sched_barrier(0); }
    } else {
#pragma unroll
      for (int i = 0; i < 64; ++i) { sol[i] = bf2f(Kn[i * 128 + (((kc >> 3) ^ (i & 15)) * 8) + (kc & 7)]) * bts[i] * egs[i]; if ((i & 7) == 7) __builtin_amdgcn_sched_barrier(0); }
    }
    __builtin_amdgcn_sched_barrier(0);
#pragma unroll
    for (int i = 1; i < 64; ++i) {
      float a = sol[i];
#pragma unroll
      for (int jb = 0; jb < (i + 3) / 4; ++jb) {
        const float4 l = *(const float4*)(Lm + i * 64 + jb * 4);
        if (jb * 4 + 0 < i) a -= l.x * sol[jb * 4 + 0];
        if (jb * 4 + 1 < i) a -= l.y * sol[jb * 4 + 1];
        if (jb * 4 + 2 < i) a -= l.z * sol[jb * 4 + 2];
        if (jb * 4 + 3 < i) a -= l.w * sol[jb * 4 + 3];
      }
      sol[i] = a;
      __builtin_amdgcn_sched_barrier(0);
    }
    bf16_t* go = gi + t + (isv ? 0 : 8192 - 128);
#pragma unroll
    for (int i = 0; i < 64; ++i) { go[i * 128] = f2bf(sol[i]); if ((i & 7) == 7) __builtin_amdgcn_sched_barrier(0); }
  }
  if (t == 0) p.glast[item] = egs[63];
}

__device__ void gdn_decode_item(const Params& p, int item, char* smem) {
  const int h = item & 3, s = item >> 2; const size_t row = NTOK + s;
  float* qs = (float*)smem; float* ks = qs + 128; float* vs = ks + 128; float* part = vs + 128; float* red = part + 512;
  const int t = threadIdx.x;
  __syncthreads();
  float cv[3] = {0.f, 0.f, 0.f};
  if (t < 128) {
#pragma unroll
    for (int X = 0; X < 3; ++X) {
      const int col = X * 512 + h * 128 + t;
      const float* buf = p.st_gdn_conv + (size_t)s * 3 * 1536 + col;
      const float b0 = buf[0], b1 = buf[1536], b2 = buf[3072];
      const float nw = p.sproj[(size_t)s * NPROJ + 512 + col];
      const float* cw = p.gdn_conv_w + col;
      const float a = b0 * cw[0] + b1 * cw[1536] + b2 * cw[3072] + nw * cw[4608];
      cv[X] = siluf_(a);
      float* ob = p.s_gdn_conv + (size_t)s * 3 * 1536 + col;
      ob[0] = b1; ob[1536] = b2; ob[3072] = nw;
    }
  }
  const float sq = block_sum(cv[0] * cv[0], red), sk = block_sum(cv[1] * cv[1], red);
  const float qn = cv[0] * rsqrtf(sq + 1e-6f) * 0.08838834764831845f, kn = cv[1] * rsqrtf(sk + 1e-6f);
  const float qk = block_sum(qn * kn, red);
  if (t < 128) { qs[t] = qn; ks[t] = kn; vs[t] = cv[2]; }
  const float beta = sigmoidf_(p.ba[row * 8 + h]);
  const float xx = p.ba[row * 8 + 4 + h] + p.dt_bias[h];
  const float eg = expf(-expf(p.a_log[h]) * (fmaxf(xx, 0.f) + log1pf(expf(-fabsf(xx)))));
  __syncthreads();
  const int e = t & 127, dh = t >> 7;
  const size_t soff = ((size_t)(s * 4 + h) * 128 + dh * 64) * 128 + e;
  const float* S0 = p.st_gdn + soff;
  float sr[64]; float kS = 0.f, qS = 0.f;
#pragma unroll
  for (int d = 0; d < 64; ++d) { sr[d] = S0[(size_t)d * 128]; kS += ks[dh * 64 + d] * sr[d]; qS += qs[dh * 64 + d] * sr[d]; }
  part[dh * 128 + e] = kS; part[256 + dh * 128 + e] = qS;
  __syncthreads();
  kS = part[e] + part[128 + e]; qS = part[256 + e] + part[384 + e];
  const float vn = beta * (vs[e] - eg * kS);
  const float o = eg * qS + qk * vn;
  float* S1 = p.s_gdn + soff;
#pragma unroll
  for (int d = 0; d < 64; ++d) S1[(size_t)d * 128] = sr[d] * eg + ks[dh * 64 + d] * vn;
  const float so = block_sum(dh == 0 ? o * o : 0.f, red);
  if (dh == 0) {
    const float z = p.sproj[(size_t)s * NPROJ + 2048 + h * 128 + e];
    p.XN[row * 1024 + 512 + h * 128 + e] = f2bf(o * rsqrtf(so * (1.f / 128.f) + 1e-6f) * p.onorm_g[e] * siluf_(z));
  }
  __syncthreads();
}

#ifndef REP_MASK
#define REP_MASK 15
#endif
template <int MASK>
DI void phase2(const Params& p, char* smem, int cofs) {
  constexpr int N_S5 = 256, N_PREP = 1024, N_SDEC = 128;
  for (;;) {
    int it = fetch_item(p.ctr + 2 + cofs);
    if (it >= N_S5 + N_PREP + N_SDEC) break;
    if (it < N_S5) { if (MASK & 1) s5_scan_item(p, it, smem); continue; }
    it -= N_S5;
    if (it < N_PREP) { if (MASK & 2) gdn_prep_item(p, it, smem); continue; }
    it -= N_PREP;
    if (MASK & 8) s5_decode_item(p, it, smem);
  }
}

__device__ void gdn_seq_item(const Params& p, int item, char* smem) {
  const int sl = item & 3, h = (item >> 2) & 3, b = item >> 4;
  bf16_t* ST = (bf16_t*)smem;
  bf16_t* VT = (bf16_t*)(smem + 8704);
  const int t = threadIdx.x, lane = t & 63, w = t >> 6, r = lane & 15, q = lane >> 4;
  __syncthreads();
  for (int i = t; i < 32 * 136; i += 256) ST[i] = 0;
  f32x4 sacc[2][2];
#pragma unroll
  for (int mi = 0; mi < 2; ++mi)
#pragma unroll
    for (int ni = 0; ni < 2; ++ni) sacc[mi][ni] = f32x4{0.f, 0.f, 0.f, 0.f};
  bf16x8 W0[4], Q0[4], A0[2], K0[2][2];
  unsigned U0[2][4]; float g0;
  const bf16_t* gbase = p.GDNI + (size_t)((b * 4 + h) * 32) * 36864;
  const float* glb = p.glast + (b * 4 + h) * 32;
#define SEQ_LOAD_WQU(S, C) { \
    const bf16_t* gi_ = gbase + (size_t)(C) * 36864; \
    _Pragma("unroll") for (int ks = 0; ks < 4; ++ks) { \
      W##S[ks] = *(const bf16x8*)(gi_ + 8192 + (w * 16 + r) * 128 + ks * 32 + q * 8); \
      Q##S[ks] = *(const bf16x8*)(gi_ + 16384 + (w * 16 + r) * 128 + ks * 32 + q * 8); } \
    _Pragma("unroll") for (int ni = 0; ni < 2; ++ni) _Pragma("unroll") for (int j = 0; j < 4; ++j) \
      U##S[ni][j] = (unsigned)gi_[(w * 16 + q * 4 + j) * 128 + sl * 32 + ni * 16 + r]; \
    g##S = glb[(C)]; }
#define SEQ_LOAD_AK(S, C) { \
    const bf16_t* gi_ = gbase + (size_t)(C) * 36864; \
    _Pragma("unroll") for (int k2 = 0; k2 < 2; ++k2) { \
      A##S[k2] = *(const bf16x8*)(gi_ + 32768 + (w * 16 + r) * 64 + k2 * 32 + q * 8); \
      _Pragma("unroll") for (int mi = 0; mi < 2; ++mi) K##S[mi][k2] = *(const bf16x8*)(gi_ + 24576 + ((2 * w + mi) * 16 + r) * 64 + k2 * 32 + q * 8); } }
#define SEQ_CHUNK(S, C) { \
    f32x4 vacc[2], oacc[2]; \
    _Pragma("unroll") for (int ni = 0; ni < 2; ++ni) { vacc[ni] = f32x4{0.f, 0.f, 0.f, 0.f}; oacc[ni] = f32x4{0.f, 0.f, 0.f, 0.f}; } \
    _Pragma("unroll") for (int ks = 0; ks < 4; ++ks) { \
      _Pragma("unroll") for (int ni = 0; ni < 2; ++ni) { \
        const bf16x8 bs = *(const bf16x8*)(ST + (ni * 16 + r) * 136 + ks * 32 + q * 8); \
        vacc[ni] = mfma16(W0[ks], bs, vacc[ni]); oacc[ni] = mfma16(bs, Q0[ks], oacc[ni]); } } \
    _Pragma("unroll") for (int ni = 0; ni < 2; ++ni) { \
      float vn[4]; \
      _Pragma("unroll") for (int j = 0; j < 4; ++j) vn[j] = __uint_as_float(U0[ni][j] << 16) - vacc[ni][j]; \
      uint2 pk; pk.x = pack2(vn[0], vn[1]); pk.y = pack2(vn[2], vn[3]); \
      *(uint2*)(VT + (ni * 16 + r) * 72 + w * 16 + q * 4) = pk; } \
    const float gl = g0; \
    __builtin_amdgcn_sched_barrier(0); \
    if ((C) + 1 < 32) SEQ_LOAD_WQU(0, (C) + 1) \
    __builtin_amdgcn_sched_barrier(0); \
    lds_barrier(); \
    bf16x8 bv[2][2]; \
    _Pragma("unroll") for (int ni = 0; ni < 2; ++ni) _Pragma("unroll") for (int k2 = 0; k2 < 2; ++k2) bv[ni][k2] = *(const bf16x8*)(VT + (ni * 16 + r) * 72 + k2 * 32 + q * 8); \
    _Pragma("unroll") for (int k2 = 0; k2 < 2; ++k2) _Pragma("unroll") for (int ni = 0; ni < 2; ++ni) oacc[ni] = mfma16(bv[ni][k2], A0[k2], oacc[ni]); \
    _Pragma("unroll") for (int mi = 0; mi < 2; ++mi) { \
      _Pragma("unroll") for (int ni = 0; ni < 2; ++ni) sacc[mi][ni] *= gl; \
      _Pragma("unroll") for (int k2 = 0; k2 < 2; ++k2) _Pragma("unroll") for (int ni = 0; ni < 2; ++ni) sacc[mi][ni] = mfma16(K0[mi][k2], bv[ni][k2], sacc[mi][ni]); } \
    __builtin_amdgcn_sched_barrier(0); \
    if ((C) + 1 < 32) SEQ_LOAD_AK(0, (C) + 1) \
    __builtin_amdgcn_sched_barrier(0); \
    _Pragma("unroll") for (int ni = 0; ni < 2; ++ni) { \
      float4 o; o.x = oacc[ni][0]; o.y = oacc[ni][1]; o.z = oacc[ni][2]; o.w = oacc[ni][3]; \
      *(float4*)(p.ogdn + ((size_t)b * 2048 + (C) * 64 + w * 16 + r) * 512 + h * 128 + sl * 32 + ni * 16 + q * 4) = o; } \
    _Pragma("unroll") for (int mi = 0; mi < 2; ++mi) _Pragma("unroll") for (int ni = 0; ni < 2; ++ni) { \
      uint2 pk; pk.x = pack2(sacc[mi][ni][0], sacc[mi][ni][1]); pk.y = pack2(sacc[mi][ni][2], sacc[mi][ni][3]); \
      *(uint2*)(ST + (ni * 16 + r) * 136 + (2 * w + mi) * 16 + q * 4) = pk; } \
    lds_barrier(); }
  SEQ_LOAD_WQU(0, 0)
  SEQ_LOAD_AK(0, 0)
  __syncthreads();
  for (int c = 0; c < 32; c += 2) {
    SEQ_CHUNK(0, c)
    SEQ_CHUNK(1, c + 1)
  }
#undef SEQ_LOAD_WQU
#undef SEQ_LOAD_AK
#undef SEQ_CHUNK
#pragma unroll
  for (int mi = 0; mi < 2; ++mi)
#pragma unroll
    for (int ni = 0; ni < 2; ++ni)
#pragma unroll
      for (int j = 0; j < 4; ++j)
        p.p_gdn[((size_t)(b * 4 + h) * 128 + (2 * w + mi) * 16 + q * 4 + j) * 128 + sl * 32 + ni * 16 + r] = sacc[mi][ni][j];
}

__device__ void glu_tile(const Params& p, int idx, char* smem) {
  const int mt = idx >> 3, nt = idx & 7;
  f32x4 acc[4][4];
  gemm_std(p.ys5, 512, mt * 128, p.WgluT, 512, nt * 128, 8, acc, smem);
  EPI_COORDS
#pragma unroll
  for (int mi = 0; mi < 4; ++mi)
#pragma unroll
    for (int ni = 0; ni < 2; ++ni) {
      const int row = mt * 128 + wm * 64 + mi * 16 + r, col = nt * 64 + wn * 32 + ni * 16 + q * 4;
      float o[4];
#pragma unroll
      for (int j = 0; j < 4; ++j) o[j] = acc[mi][ni][j] * sigmoidf_(acc[mi][ni + 2][j]);
      uint2 pk; pk.x = pack2(o[0], o[1]); pk.y = pack2(o[2], o[3]);
      *(uint2*)(p.XN + (size_t)row * 1024 + col) = pk;
    }
}

template <int MASK>
DI void phase3(const Params& p, char* smem, int cofs) {
  constexpr int N_SEQ = 128, N_GLU = 129 * 8, N_GDEC = 512;
  for (;;) {
    int it = fetch_item(p.ctr + 3 + cofs);
    if (it >= N_SEQ + N_GLU + N_GDEC) break;
    if (it < N_SEQ) { if (MASK & 1) gdn_seq_item(p, it, smem); }
    else if (it < N_SEQ + N_GLU) { if (MASK & 2) glu_tile(p, it - N_SEQ, smem); }
    else { if (MASK & 2) gdn_decode_item(p, it - N_SEQ - N_GLU, smem); }
  }
}

__device__ void phase4(const Params& p) {
  const int lane = threadIdx.x & 63, w = threadIdx.x >> 6;
  for (int i = blockIdx.x * 256 + threadIdx.x; i < 128 * 1024 / 4; i += gridDim.x * 256)
    *(float4*)(p.out + (size_t)NTOK * 1024 + (size_t)i * 4) = *(const float4*)(p.x_sample + (size_t)i * 4);
  for (int it = blockIdx.x; it < NTOK / 4; it += gridDim.x) {
    const size_t row = (size_t)it * 4 + w;
    const float* op = p.ogdn + row * 512 + lane * 8;
    const float4 o0 = *(const float4*)op, o1 = *(const float4*)(op + 4);
    float ss = o0.x * o0.x + o0.y * o0.y + o0.z * o0.z + o0.w * o0.w + o1.x * o1.x + o1.y * o1.y + o1.z * o1.z + o1.w * o1.w;
    ss += __shfl_xor(ss, 1); ss += __shfl_xor(ss, 2); ss += __shfl_xor(ss, 4); ss += __shfl_xor(ss, 8);
    const float rs = rsqrtf(ss * (1.f / 128.f) + 1e-6f);
    const uint4 zr = *(const uint4*)(p.PROJ + row * NPROJ + 2048 + lane * 8);
    const float* gp = p.onorm_g + (lane & 15) * 8;
    const float4 g0 = *(const float4*)gp, g1 = *(const float4*)(gp + 4);
    uint4 pk;
    pk.x = pack2(o0.x * rs * g0.x * siluf_(bflo(zr.x)), o0.y * rs * g0.y * siluf_(bfhi(zr.x)));
    pk.y = pack2(o0.z * rs * g0.z * siluf_(bflo(zr.y)), o0.w * rs * g0.w * siluf_(bfhi(zr.y)));
    pk.z = pack2(o1.x * rs * g1.x * siluf_(bflo(zr.z)), o1.y * rs * g1.y * siluf_(bfhi(zr.z)));
    pk.w = pack2(o1.z * rs * g1.z * siluf_(bflo(zr.w)), o1.w * rs * g1.w * siluf_(bfhi(zr.w)));
    *(uint4*)(p.XN + row * 1024 + 512 + lane * 8) = pk;
  }
}

__device__ void phase5(const Params& p, char* smem, int vb) {
  for (int step = 0;; ++step) {
    int mt, nt; bool valid;
    if (!get_tile(vb, step, 128, 8, 8, mt, nt, valid)) break;
    if (!valid) continue;
    f32x4 acc[4][4];
    gemm_std(p.XN, 1024, mt * 128, p.WoutT, 1024, nt * 128, 16, acc, smem);
    EPI_COORDS
#pragma unroll
    for (int mi = 0; mi < 4; ++mi) {
      const int row = mt * 128 + wm * 64 + mi * 16 + r;
      const float* xr = xin_row(p, row);
      float4 xv[4];
#pragma unroll
      for (int ni = 0; ni < 4; ++ni) xv[ni] = *(const float4*)(xr + nt * 128 + wn * 64 + ni * 16 + q * 4);
#pragma unroll
      for (int ni = 0; ni < 4; ++ni) {
        float4 o; o.x = xv[ni].x + acc[mi][ni][0]; o.y = xv[ni].y + acc[mi][ni][1]; o.z = xv[ni].z + acc[mi][ni][2]; o.w = xv[ni].w + acc[mi][ni][3];
        *(float4*)(p.out + (size_t)row * 1024 + nt * 128 + wn * 64 + ni * 16 + q * 4) = o;
      }
    }
  }
  if (vb < 32) sample_splitk_task(p.out + (size_t)NTOK * 1024, 1024, p.XN, 1024, p.WoutT, 1024, vb & 7, vb >> 3, smem);
}

__device__ void phase_norm(const Params& p, bool final_) {
  const int lane = threadIdx.x & 63, w = threadIdx.x >> 6;
  const float* gw = final_ ? p.normf_g : p.norm2_g;
  float4 g[4];
#pragma unroll
  for (int i = 0; i < 4; ++i) g[i] = *(const float4*)(gw + i * 256 + lane * 4);
  for (int it = blockIdx.x; it < MROWS / 8; it += gridDim.x) {
    float4 v[2][4];
#pragma unroll
    for (int rr = 0; rr < 2; ++rr)
#pragma unroll
      for (int i = 0; i < 4; ++i) v[rr][i] = *(const float4*)(p.out + ((size_t)it * 8 + rr * 4 + w) * 1024 + i * 256 + lane * 4);
#pragma unroll
    for (int rr = 0; rr < 2; ++rr) {
      const size_t row = (size_t)it * 8 + rr * 4 + w;
      float* xr = p.out + row * 1024;
      float ss = 0.f;
#pragma unroll
      for (int i = 0; i < 4; ++i) ss += v[rr][i].x * v[rr][i].x + v[rr][i].y * v[rr][i].y + v[rr][i].z * v[rr][i].z + v[rr][i].w * v[rr][i].w;
      ss = wave_sum(ss);
      const float rstd = rsqrtf(ss * (1.f / 1024.f) + 1e-6f);
#pragma unroll
      for (int i = 0; i < 4; ++i) {
        float4 o; o.x = v[rr][i].x * rstd * g[i].x; o.y = v[rr][i].y * rstd * g[i].y; o.z = v[rr][i].z * rstd * g[i].z; o.w = v[rr][i].w * rstd * g[i].w;
        if (final_) *(float4*)(xr + i * 256 + lane * 4) = o;
        else { uint2 pk; pk.x = pack2(o.x, o.y); pk.y = pack2(o.z, o.w); *(uint2*)(p.XN + row * 1024 + i * 256 + lane * 4) = pk; }
      }
    }
  }
}

__device__ void phase7(const Params& p, char* smem, int vb) {
  constexpr int NT = 44, MT = 137;
  float* hl = (float*)smem;
  for (int step = 0;; ++step) {
    int mt, nt;
    if (!get_tile_strip(vb, step, MT, NT, 4, mt, nt)) break;
    const bool samp = mt == 136;
    const int bb = mt / 17, ii = mt % 17;
    f32x4 acc[4][4];
    {
      const int t = threadIdx.x;
      unsigned amask = 0;
      long arow0;
      if (samp) { arow0 = NTOK + (t >> 3); amask = 0xfu; }
      else {
        arow0 = (long)bb * 2048 + 126 * ii - 2 + (t >> 3);
#pragma unroll
        for (int i = 0; i < 4; ++i) { const int tok = 126 * ii - 2 + (t >> 3) + 32 * i; if (tok >= 0 && tok < 2048) amask |= 1u << i; }
      }
      const bf16_t* a0 = p.XN + arow0 * 1024 + (t & 7) * 8;
      const bf16_t* b0 = p.WupT + (size_t)(nt * 128 + (t >> 3)) * 1024 + (t & 7) * 8;
      gemm_main<true>(a0, (size_t)32 * 1024, amask, b0, (size_t)32 * 1024, 16, acc, smem);
    }
    EPI_COORDS
    __syncthreads();
#pragma unroll
    for (int mi = 0; mi < 4; ++mi)
#pragma unroll
      for (int ni = 0; ni < 4; ++ni)
#pragma unroll
        for (int j = 0; j < 4; ++j) hl[(wm * 64 + mi * 16 + r) * 132 + wn * 64 + ni * 16 + q * 4 + j] = acc[mi][ni][j];
    __syncthreads();
    {
      const int jp = t & 31, rbase = (t >> 5) * 16;
      const int hsel = jp >> 4, lc = hsel * 64 + 2 * (jp & 15);
      const int colp = nt * 64 + hsel * 32 + 2 * (jp & 15);
      const float2 wg0 = *(const float2*)(p.ffn_conv_w + colp), wg1 = *(const float2*)(p.ffn_conv_w + 5632 + colp), wg2 = *(const float2*)(p.ffn_conv_w + 2 * 5632 + colp);
      const float2 wu0 = *(const float2*)(p.ffn_conv_w + 2816 + colp), wu1 = *(const float2*)(p.ffn_conv_w + 5632 + 2816 + colp), wu2 = *(const float2*)(p.ffn_conv_w + 2 * 5632 + 2816 + colp);
      if (samp) {
#pragma unroll 2
        for (int rr = 0; rr < 16; ++rr) {
          const int sidx = rbase + rr;
          const float* sb = p.st_ffn_conv + (size_t)sidx * 2 * 5632;
          const float2 g0 = *(const float2*)(sb + colp), g1 = *(const float2*)(sb + 5632 + colp), u0 = *(const float2*)(sb + 2816 + colp), u1 = *(const float2*)(sb + 5632 + 2816 + colp);
          const float2 hg = *(const float2*)(hl + sidx * 132 + lc), hu = *(const float2*)(hl + sidx * 132 + lc + 32);
          const float ga = g0.x * wg0.x + g1.x * wg1.x + hg.x * wg2.x, gb = g0.y * wg0.y + g1.y * wg1.y + hg.y * wg2.y;
          const float ua = u0.x * wu0.x + u1.x * wu1.x + hu.x * wu2.x, ub = u0.y * wu0.y + u1.y * wu1.y + hu.y * wu2.y;
          *(unsigned*)(p.ACT + (size_t)(NTOK + sidx) * 2816 + colp) = pack2(siluf_(ga) * ua, siluf_(gb) * ub);
          float* ob = p.s_ffn_conv + (size_t)sidx * 2 * 5632;
          *(float2*)(ob + colp) = g1; *(float2*)(ob + 2816 + colp) = u1; *(float2*)(ob + 5632 + colp) = hg; *(float2*)(ob + 5632 + 2816 + colp) = hu;
        }
      } else {
        float2 ga = make_float2(0.f, 0.f), gb = ga, ua = ga, ub = ga;
        if (rbase >= 2) {
          ga = *(const float2*)(hl + (rbase - 2) * 132 + lc); gb = *(const float2*)(hl + (rbase - 1) * 132 + lc);
          ua = *(const float2*)(hl + (rbase - 2) * 132 + lc + 32); ub = *(const float2*)(hl + (rbase - 1) * 132 + lc + 32);
        }
#pragma unroll 4
        for (int rr = 0; rr < 16; ++rr) {
          const int rowt = rbase + rr;
          const int tok = 126 * ii - 2 + rowt;
          float2 gc = *(const float2*)(hl + rowt * 132 + lc), uc = *(const float2*)(hl + rowt * 132 + lc + 32);
          if (tok < 0) { gc = make_float2(0.f, 0.f); uc = gc; }
          if (rowt >= 2 && tok < 2048) {
            const float g0 = ga.x * wg0.x + gb.x * wg1.x + gc.x * wg2.x, g1 = ga.y * wg0.y + gb.y * wg1.y + gc.y * wg2.y;
            const float u0 = ua.x * wu0.x + ub.x * wu1.x + uc.x * wu2.x, u1 = ua.y * wu0.y + ub.y * wu1.y + uc.y * wu2.y;
            *(unsigned*)(p.ACT + ((size_t)bb * 2048 + tok) * 2816 + colp) = pack2(siluf_(g0) * u0, siluf_(g1) * u1);
            if (tok >= 2046) {
              float* ob = p.p_ffn_conv + (size_t)(bb * 2 + (tok - 2046)) * 5632;
              *(float2*)(ob + colp) = gc; *(float2*)(ob + 2816 + colp) = uc;
            }
          }
          ga = gb; gb = gc; ua = ub; ub = uc;
        }
      }
    }
  }
}

__device__ void phase8(const Params& p, char* smem, int vb) {
  for (int step = 0;; ++step) {
    int mt, nt; bool valid;
    if (!get_tile(vb, step, 128, 8, 8, mt, nt, valid)) break;
    if (!valid) continue;
    f32x4 acc[4][4];
    gemm_std(p.ACT, 2816, mt * 128, p.WdnT, 2816, nt * 128, 44, acc, smem);
    EPI_COORDS
#pragma unroll
    for (int mi = 0; mi < 4; ++mi) {
      float* orow = p.out + (size_t)(mt * 128 + wm * 64 + mi * 16 + r) * 1024 + nt * 128 + wn * 64 + q * 4;
      float4 xv[4];
#pragma unroll
      for (int ni = 0; ni < 4; ++ni) xv[ni] = *(const float4*)(orow + ni * 16);
#pragma unroll
      for (int ni = 0; ni < 4; ++ni) {
        float4 o; o.x = xv[ni].x + acc[mi][ni][0]; o.y = xv[ni].y + acc[mi][ni][1]; o.z = xv[ni].z + acc[mi][ni][2]; o.w = xv[ni].w + acc[mi][ni][3];
        *(float4*)(orow + ni * 16) = o;
      }
    }
  }
  if (vb < 88) sample_splitk_task(p.out + (size_t)NTOK * 1024, 1024, p.ACT, 2816, p.WdnT, 2816, vb & 7, vb >> 3, smem);
}

template <int PH>
DI void run_phase(const Params& p, char* smem, int vb, int cofs = 0) {
  if (PH == 0) phase0(p, smem);
  else if (PH == 1) { if (cofs) phase1<REP_MODE + 10 * 0>(p, smem, vb); else phase1<0>(p, smem, vb); }
  else if (PH == 2) { if (cofs) phase2<REP_MASK>(p, smem, cofs); else phase2<15>(p, smem, 0); }
  else if (PH == 3) { if (cofs) phase3<(REP_MASK & 3)>(p, smem, cofs); else phase3<3>(p, smem, 0); }
  else if (PH == 4) phase4(p);
  else if (PH == 5) phase5(p, smem, vb);
  else if (PH == 6) phase_norm(p, false);
  else if (PH == 7) phase7(p, smem, vb);
  else if (PH == 8) phase8(p, smem, vb);
  else phase_norm(p, true);
}

template <int PH>
__global__ void __launch_bounds__(256, 2) phase_kernel(Params p) {
  __shared__ __attribute__((aligned(16))) char smem[SMEM_BYTES];
  run_phase<PH>(p, smem, blockIdx.x);
}


#define XB_TMO      128
#define XB_XCNT(j)  (256  + 64 * (j))
#define XB_XSUB(j)  (1280 + 64 * (j))
#define XB_XGEN(j)  (2304 + 64 * (j))
#define XB_TOP      3328
#define XB_TOPGEN   3392
#define XCD_BAR_WORDS 3456
#define XB_SPIN_CAP (1u << 18)
#define LAS __attribute__((address_space(3)))
DI unsigned xb_ld(unsigned* p) { return __hip_atomic_load(p, __ATOMIC_RELAXED, __HIP_MEMORY_SCOPE_AGENT); }
DI unsigned xb_add(unsigned* p, unsigned v) { return __hip_atomic_fetch_add(p, v, __ATOMIC_RELAXED, __HIP_MEMORY_SCOPE_AGENT); }
DI unsigned xb_xcc_id() { return (unsigned)__builtin_amdgcn_s_getreg((3 << 11) | 20) & 0xFu; }
#define XB_SPIN(cond, bar) do { unsigned _sp = 0; while (cond) { __builtin_amdgcn_s_sleep(1); \
    if ((++_sp & 255u) == 0u) { if (xb_ld(&(bar)[XB_TMO])) break; if (_sp > XB_SPIN_CAP) { atomicAdd(&(bar)[XB_TMO], 1u); break; } } } } while (0)
struct XcdBarrier { unsigned* bar; unsigned x; volatile LAS unsigned* st; };
DI XcdBarrier xcd_barrier_post(unsigned* bar, volatile LAS unsigned* st) {
  XcdBarrier b; b.bar = bar; b.x = xb_xcc_id(); b.st = st;
  if (threadIdx.x == 0) (void)xb_add(&bar[XB_XCNT(b.x)], 1u);
  return b;
}
DI void xcd_barrier_complete(unsigned* bar, unsigned x, unsigned& nloc, unsigned& nx) {
  const unsigned G = gridDim.x * gridDim.y * gridDim.z;
  unsigned sum, cnt, mine, sp = 0u;
  for (;;) {
    sum = 0u; cnt = 0u; mine = 0u;
#pragma unroll
    for (unsigned j = 0; j < 16; ++j) { const unsigned c = xb_ld(&bar[XB_XCNT(j)]); sum += c; cnt += (c > 0u) ? 1u : 0u; mine = (j == x) ? c : mine; }
    if (sum == G) break;
    __builtin_amdgcn_s_sleep(1);
    if ((++sp & 255u) == 0u) { if (xb_ld(&bar[XB_TMO])) break; if (sp > XB_SPIN_CAP) { atomicAdd(&bar[XB_TMO], 1u); break; } }
  }
  nloc = mine > 0u ? mine : 1u; nx = cnt > 0u ? cnt : 1u;
}
DI void xcd_barrier(const XcdBarrier& b) {
  asm volatile("s_waitcnt vmcnt(0)" ::: "memory");
  __syncthreads();
  if (threadIdx.x == 0) {
    unsigned* bar = b.bar;
    __builtin_amdgcn_s_waitcnt(0);
    unsigned nloc = b.st[0], nx = b.st[1];
    if (nloc == 0u) { xcd_barrier_complete(bar, b.x, nloc, nx); b.st[0] = nloc; b.st[1] = nx; }
    const unsigned old = xb_add(&bar[XB_XSUB(b.x)], 1u);
    const unsigned gen = old / nloc;
    if (old + 1u == (gen + 1u) * nloc) {
      __builtin_amdgcn_fence(__ATOMIC_RELEASE, "agent");
      asm volatile("s_waitcnt vmcnt(0)" ::: "memory");
      const unsigned og = xb_add(&bar[XB_TOP], 1u);
      const unsigned tg = og / nx;
      if (og + 1u == (tg + 1u) * nx) xb_add(&bar[XB_TOPGEN], 1u);
      else XB_SPIN(xb_ld(&bar[XB_TOPGEN]) == tg, bar);
      __builtin_amdgcn_fence(__ATOMIC_ACQUIRE, "agent");
      xb_add(&bar[XB_XGEN(b.x)], 1u);
      asm volatile("s_waitcnt vmcnt(0)" ::: "memory");
    } else {
      XB_SPIN(xb_ld(&bar[XB_XGEN(b.x)]) == gen, bar);
      __builtin_amdgcn_fence(__ATOMIC_ACQUIRE, "agent");
      asm volatile("s_waitcnt vmcnt(0)" ::: "memory");
    }
  }
  __syncthreads();
}

__shared__ int s_vb;
__shared__ uint4 xb_words;
__global__ void __launch_bounds__(256, 2) fwd_megakernel(Params p) {
  __shared__ __attribute__((aligned(16))) char smem[SMEM_BYTES];
  if (p.bar == nullptr) cg::this_grid().sync();
  if (threadIdx.x == 0) xb_words = make_uint4(0u, 0u, 0u, 0u);
  __syncthreads();
  XcdBarrier xb = xcd_barrier_post(p.bar, (volatile LAS unsigned*)&xb_words);
  int xloc = 0;
  if (threadIdx.x == 0) xloc = atomicAdd(p.ctr + 16 + (int)(xb.x & 7u), 1);
  run_phase<0>(p, smem, blockIdx.x); xcd_barrier(xb);
#if defined(REP_PHASE) && REP_PHASE == 0
  run_phase<0>(p, smem, blockIdx.x); xcd_barrier(xb);
#endif
  if (threadIdx.x == 0) {
    bool even = (gridDim.x & 7) == 0;
    for (int i = 0; i < 8; ++i) even = even && (__hip_atomic_load(p.ctr + 16 + i, __ATOMIC_RELAXED, __HIP_MEMORY_SCOPE_AGENT) == (int)(gridDim.x >> 3));
    s_vb = even ? xloc * 8 + (int)(xb.x & 7u) : (int)blockIdx.x;
  }
  __syncthreads();
  const int vb = s_vb;
  run_phase<1>(p, smem, vb); xcd_barrier(xb);
#if defined(REP_PHASE) && REP_PHASE == 1
  run_phase<1>(p, smem, vb, 8); xcd_barrier(xb);
#endif
  run_phase<2>(p, smem, vb); xcd_barrier(xb);
#if defined(REP_PHASE) && REP_PHASE == 2
  run_phase<2>(p, smem, vb, 8); xcd_barrier(xb);
#endif
  run_phase<3>(p, smem, vb); xcd_barrier(xb);
#if defined(REP_PHASE) && REP_PHASE == 3
  run_phase<3>(p, smem, vb, 8); xcd_barrier(xb);
#endif
  run_phase<4>(p, smem, vb); xcd_barrier(xb);
#if defined(REP_PHASE) && REP_PHASE == 4
  run_phase<4>(p, smem, vb, 8); xcd_barrier(xb);
#endif
  run_phase<5>(p, smem, vb); xcd_barrier(xb);
#if defined(REP_PHASE) && REP_PHASE == 5
  run_phase<5>(p, smem, vb, 8); xcd_barrier(xb);
#endif
  run_phase<6>(p, smem, vb); xcd_barrier(xb);
#if defined(REP_PHASE) && REP_PHASE == 6
  run_phase<6>(p, smem, vb, 8); xcd_barrier(xb);
#endif
  run_phase<7>(p, smem, vb); xcd_barrier(xb);
#if defined(REP_PHASE) && REP_PHASE == 7
  run_phase<7>(p, smem, vb, 8); xcd_barrier(xb);
#endif
  run_phase<8>(p, smem, vb); xcd_barrier(xb);
#if defined(REP_PHASE) && REP_PHASE == 8
  run_phase<8>(p, smem, vb, 8); xcd_barrier(xb);
#endif
  run_phase<9>(p, smem, vb);
}

extern "C" void kernel_launch(void* const* d_in, const int* in_sizes, int n_in, void* d_out, int out_size, void* d_ws, size_t ws_size, hipStream_t stream) {
  static int grid_blocks = 0;
  if (!grid_blocks) {
    int dev = 0, cus = 0, per_cu = 0;
    (void)hipGetDevice(&dev);
    (void)hipDeviceGetAttribute(&cus, hipDeviceAttributeMultiprocessorCount, dev);
    (void)hipOccupancyMaxActiveBlocksPerMultiprocessor(&per_cu, fwd_megakernel, 256, 0);
    if (per_cu < 1) per_cu = 1;
    if (per_cu > 2) per_cu = 2;
    grid_blocks = cus * per_cu;
  }
  Params p{};
  const float* const* in = (const float* const*)d_in;
  p.x_prompt = in[0]; p.x_sample = in[1]; p.st_s5_re = in[2]; p.st_s5_im = in[3]; p.st_gdn = in[4]; p.st_gdn_conv = in[5]; p.st_ffn_conv = in[6];
  p.norm1_g = in[7]; p.w_in = in[8]; p.a_re = in[9]; p.a_im = in[10]; p.log_dt = in[11]; p.b_re = in[12]; p.b_im = in[13]; p.c_re = in[14]; p.c_im = in[15];
  p.s5_d = in[16]; p.w_glu = in[17]; p.gdn_conv_w = in[18]; p.a_log = in[19]; p.dt_bias = in[20]; p.onorm_g = in[21]; p.w_out = in[22]; p.norm2_g = in[23];
  p.w_up = in[24]; p.ffn_conv_w = in[25]; p.w_down = in[26]; p.normf_g = in[27];
  float* o = (float*)d_out;
  p.out = o;
  size_t off = (size_t)MROWS * 1024;
  p.p_s5_re = o + off; off += 8 * 32 * 64;
  p.p_s5_im = o + off; off += 8 * 32 * 64;
  p.p_gdn = o + off; off += (size_t)8 * 4 * 128 * 128;
  p.p_gdn_conv = o + off; off += 8 * 3 * 1536;
  p.p_ffn_conv = o + off; off += 8 * 2 * 5632;
  p.s_s5_re = o + off; off += 128 * 32 * 64;
  p.s_s5_im = o + off; off += 128 * 32 * 64;
  p.s_gdn = o + off; off += (size_t)128 * 4 * 128 * 128;
  p.s_gdn_conv = o + off; off += 128 * 3 * 1536;
  p.s_ffn_conv = o + off; off += 128 * 2 * 5632;
  p.ogdn = o;
  p.ys5 = (bf16_t*)(o + (size_t)NTOK * 512);
  char* ws = (char*)d_ws;
  size_t wo = 0;
  auto take = [&](size_t bytes) { char* r = ws + wo; wo += (bytes + 255) & ~(size_t)255; return r; };
  p.ctr = (int*)take(256);
  p.bar = (unsigned*)take(XCD_BAR_WORDS * 4);
  p.ba = (float*)take((size_t)MROWS * 8 * 4);
  p.glast = (float*)take(1024 * 4);
  p.sproj = (float*)take((size_t)128 * NPROJ * 4);
  p.WinT = (bf16_t*)take((size_t)2560 * 1024 * 2);
  p.WgluT = (bf16_t*)take((size_t)1024 * 512 * 2);
  p.WoutT = (bf16_t*)take((size_t)1024 * 1024 * 2);
  p.WupT = (bf16_t*)take((size_t)5632 * 1024 * 2);
  p.WdnT = (bf16_t*)take((size_t)1024 * 2816 * 2);
  p.XN = (bf16_t*)take((size_t)MROWS * 1024 * 2);
  p.PROJ = (bf16_t*)take((size_t)MROWS * NPROJ * 2);
  p.ACT = p.PROJ;
  p.GDNI = (bf16_t*)take((size_t)1024 * 36864 * 2);
  if (wo > ws_size) { fprintf(stderr, "workspace too small: need %zu have %zu\n", wo, ws_size); return; }
  (void)hipMemsetAsync(p.ctr, 0, 256 + ((XCD_BAR_WORDS * 4 + 255) & ~255), stream);
#if MK_MULTI
  phase_kernel<0><<<grid_blocks, 256, 0, stream>>>(p);
  phase_kernel<1><<<grid_blocks, 256, 0, stream>>>(p);
  phase_kernel<2><<<grid_blocks, 256, 0, stream>>>(p);
  phase_kernel<3><<<grid_blocks, 256, 0, stream>>>(p);
  phase_kernel<4><<<grid_blocks, 256, 0, stream>>>(p);
  phase_kernel<5><<<grid_blocks, 256, 0, stream>>>(p);
  phase_kernel<6><<<grid_blocks, 256, 0, stream>>>(p);
  phase_kernel<7><<<grid_blocks, 256, 0, stream>>>(p);
  phase_kernel<8><<<grid_blocks, 256, 0, stream>>>(p);
  phase_kernel<9><<<grid_blocks, 256, 0, stream>>>(p);
#else
  void* args[] = {&p};
  hipError_t e = hipLaunchCooperativeKernel((void*)fwd_megakernel, dim3(grid_blocks), dim3(256), args, 0, stream);
  if (e != hipSuccess) fprintf(stderr, "cooperative launch failed: %s (grid %d)\n", hipGetErrorString(e), grid_blocks);
#endif
}
```

```cpp
#include <hip/hip_runtime.h>
#include <hip/hip_cooperative_groups.h>
#include <cstdio>
namespace cg = cooperative_groups;

#ifndef MK_MULTI
#define MK_MULTI 0
#endif

typedef unsigned short bf16_t;
using bf16x8 = __attribute__((ext_vector_type(8))) short;
using f32x4 = __attribute__((ext_vector_type(4))) float;
using u32x4 = __attribute__((ext_vector_type(4))) unsigned;

#define DI __device__ __forceinline__

typedef __bf16 bf16x2_t __attribute__((ext_vector_type(2)));
typedef float f32x2_t __attribute__((ext_vector_type(2)));
DI bf16_t f2bf(float x) { __bf16 h = (__bf16)x; return __builtin_bit_cast(bf16_t, h); }
DI float bf2f(bf16_t b) { return __uint_as_float(((unsigned)b) << 16); }
DI unsigned pack2(float a, float b) { f32x2_t v = {a, b}; bf16x2_t r = __builtin_convertvector(v, bf16x2_t); return __builtin_bit_cast(unsigned, r); }
DI float bflo(unsigned u) { return __uint_as_float(u << 16); }
DI float bfhi(unsigned u) { return __uint_as_float(u & 0xffff0000u); }
DI float sigmoidf_(float x) { return 1.f / (1.f + __expf(-x)); }
DI float siluf_(float x) { return x / (1.f + __expf(-x)); }
DI float geluf_(float x) { float u = 0.7978845608028654f * (x + 0.044715f * x * x * x); float th = 1.f - 2.f / (1.f + __expf(2.f * u)); return 0.5f * x * (1.f + th); }
DI float wave_sum(float v) { for (int o = 32; o > 0; o >>= 1) v += __shfl_xor(v, o); return v; }
DI f32x4 mfma16(bf16x8 a, bf16x8 b, f32x4 c) { return __builtin_amdgcn_mfma_f32_16x16x32_bf16(a, b, c, 0, 0, 0); }

constexpr int NTOK = 16384;
constexpr int MROWS = 16512;
constexpr int NPROJ = 2560;
constexpr int SMEM_BYTES = 67584;

struct Params {
  const float *x_prompt, *x_sample, *st_s5_re, *st_s5_im, *st_gdn, *st_gdn_conv, *st_ffn_conv;
  const float *norm1_g, *w_in, *a_re, *a_im, *log_dt, *b_re, *b_im, *c_re, *c_im, *s5_d, *w_glu;
  const float *gdn_conv_w, *a_log, *dt_bias, *onorm_g, *w_out, *norm2_g, *w_up, *ffn_conv_w, *w_down, *normf_g;
  float *out;
  float *p_s5_re, *p_s5_im, *p_gdn, *p_gdn_conv, *p_ffn_conv, *s_s5_re, *s_s5_im, *s_gdn, *s_gdn_conv, *s_ffn_conv;
  float *ogdn;
  bf16_t *ys5;
  int *ctr; unsigned *bar; float *ba; float *glast; float *sproj;
  bf16_t *WinT, *WgluT, *WoutT, *WupT, *WdnT, *XN, *PROJ, *GDNI, *ACT;
};

DI const float* xin_row(const Params& p, int row) {
  return row < NTOK ? p.x_prompt + (size_t)row * 1024 : p.x_sample + (size_t)(row - NTOK) * 1024;
}

__shared__ int s_item;
DI int fetch_item(int* ctr) {
  __syncthreads();
  if (threadIdx.x == 0) s_item = atomicAdd(ctr, 1);
  __syncthreads();
  return s_item;
}

DI void lds_barrier() { asm volatile("s_waitcnt lgkmcnt(0)\n\ts_barrier" ::: "memory"); }

DI float block_sum(float v, float* red) {
  v = wave_sum(v);
  __syncthreads();
  if ((threadIdx.x & 63) == 0) red[threadIdx.x >> 6] = v;
  __syncthreads();
  return red[0] + red[1] + red[2] + red[3];
}

DI void transpose_item(const float* src, int ldsrc, int srccol0, int k0, bf16_t* dst, int lddst, int r0, float* tl) {
  const int t = threadIdx.x;
  float v[4][8];
  { const int jj = t & 31, kk = t >> 5;
#pragma unroll
    for (int kb = 0; kb < 4; ++kb)
#pragma unroll
      for (int i = 0; i < 8; ++i) v[kb][i] = src[(size_t)(k0 + kb * 64 + kk + 8 * i) * ldsrc + srccol0 + jj]; }
#pragma unroll
  for (int kb = 0; kb < 4; ++kb) {
    { const int jj = t & 31, kk = t >> 5;
#pragma unroll
      for (int i = 0; i < 8; ++i) tl[(kk + 8 * i) * 33 + jj] = v[kb][i]; }
    __syncthreads();
    { const int kk = t & 63, jj = t >> 6;
#pragma unroll
      for (int i = 0; i < 8; ++i) dst[(size_t)(r0 + jj + 4 * i) * lddst + k0 + kb * 64 + kk] = f2bf(tl[kk * 33 + jj + 4 * i]); }
    __syncthreads();
  }
}

DI int perm_col(int r0, int halfoff) {
  const int tt = r0 >> 7, rr = r0 & 127, wn = rr >> 6, half = (rr >> 5) & 1;
  return half * halfoff + tt * 64 + wn * 32;
}

__device__ void phase0(const Params& p, char* smem) {
  float* wt = (float*)smem;
  float* tl = (float*)(smem + 32768);
  for (int i = threadIdx.x; i < 8192; i += 256) { const int k = i >> 3, j = i & 7; wt[j * 1024 + k] = p.w_in[(size_t)k * 2568 + 2560 + j]; }
  __syncthreads();
  for (int i = blockIdx.x * 256 + threadIdx.x; i < 128 * NPROJ / 4; i += gridDim.x * 256) *(float4*)(p.sproj + (size_t)i * 4) = make_float4(0.f, 0.f, 0.f, 0.f);
  constexpr int NT_IN = 320, NT_GLU = 64, NT_OUT = 128, NT_UP = 704, NT_DN = 352;
  constexpr int nT = NT_IN + NT_GLU + NT_OUT + NT_UP + NT_DN;
  constexpr int nRow = MROWS / 8;
  for (int it = blockIdx.x; it < nT + nRow; it += gridDim.x) {
    if (it < nT) {
      int i = it;
      if (i < NT_IN) { const int r0 = (i >> 2) * 32, k0 = (i & 3) * 256; transpose_item(p.w_in, 2568, r0, k0, p.WinT, 1024, r0, tl); continue; }
      i -= NT_IN;
      if (i < NT_GLU) { const int r0 = (i >> 1) * 32, k0 = (i & 1) * 256; transpose_item(p.w_glu, 1024, perm_col(r0, 512), k0, p.WgluT, 512, r0, tl); continue; }
      i -= NT_GLU;
      if (i < NT_OUT) { const int r0 = (i >> 2) * 32, k0 = (i & 3) * 256; transpose_item(p.w_out, 1024, r0, k0, p.WoutT, 1024, r0, tl); continue; }
      i -= NT_OUT;
      if (i < NT_UP) { const int r0 = (i >> 2) * 32, k0 = (i & 3) * 256; transpose_item(p.w_up, 5632, perm_col(r0, 2816), k0, p.WupT, 1024, r0, tl); continue; }
      i -= NT_UP;
      { const int r0 = (i / 11) * 32, k0 = (i % 11) * 256; transpose_item(p.w_down, 1024, r0, k0, p.WdnT, 2816, r0, tl); }
    } else {
      const int lane = threadIdx.x & 63, w = threadIdx.x >> 6;
      float4 v2[2][4];
#pragma unroll
      for (int rr = 0; rr < 2; ++rr) {
        const float* xr = xin_row(p, (it - nT) * 8 + rr * 4 + w);
#pragma unroll
        for (int i = 0; i < 4; ++i) v2[rr][i] = *(const float4*)(xr + i * 256 + lane * 4);
      }
#pragma unroll
      for (int rr = 0; rr < 2; ++rr) {
        const int row = (it - nT) * 8 + rr * 4 + w;
        float4 v[4]; float ss = 0.f;
#pragma unroll
        for (int i = 0; i < 4; ++i) { v[i] = v2[rr][i]; ss += v[i].x * v[i].x + v[i].y * v[i].y + v[i].z * v[i].z + v[i].w * v[i].w; }
        ss = wave_sum(ss);
        const float rstd = rsqrtf(ss * (1.f / 1024.f) + 1e-6f);
        float acc[8];
#pragma unroll
        for (int j = 0; j < 8; ++j) acc[j] = 0.f;
#pragma unroll
        for (int i = 0; i < 4; ++i) {
          const float4 g = *(const float4*)(p.norm1_g + i * 256 + lane * 4);
          v[i].x *= rstd * g.x; v[i].y *= rstd * g.y; v[i].z *= rstd * g.z; v[i].w *= rstd * g.w;
          uint2 pk; pk.x = pack2(v[i].x, v[i].y); pk.y = pack2(v[i].z, v[i].w);
          *(uint2*)(p.XN + (size_t)row * 1024 + i * 256 + lane * 4) = pk;
#pragma unroll
          for (int j = 0; j < 8; ++j) { const float4 wv = *(const float4*)(wt + j * 1024 + i * 256 + lane * 4); acc[j] += v[i].x * wv.x + v[i].y * wv.y + v[i].z * wv.z + v[i].w * wv.w; }
        }
#pragma unroll
        for (int j = 0; j < 8; ++j) acc[j] = wave_sum(acc[j]);
        if (lane == 0) {
          *(float4*)(p.ba + (size_t)row * 8) = make_float4(acc[0], acc[1], acc[2], acc[3]);
          *(float4*)(p.ba + (size_t)row * 8 + 4) = make_float4(acc[4], acc[5], acc[6], acc[7]);
        }
      }
    }
  }
}

template <bool NULLCHK, int PMODE = 0>
DI void gemm_main(const bf16_t* a0, size_t astr, unsigned amask, const bf16_t* b0, size_t bstr, int nk, f32x4 (&acc)[4][4], char* smem) {
  char* As = smem;
  char* Bs = smem + 16384;
  const int t = threadIdx.x, lane = t & 63, w = t >> 6, wm = w >> 1, wn = w & 1, r = lane & 15, q = lane >> 4;
  const u32x4 z4 = u32x4{0u, 0u, 0u, 0u};
  u32x4 ra0[4], rb0[4];
  const int soff = (t >> 3) * 128 + (((t & 7) ^ ((t >> 3) & 7)) * 16);
  const int aoff = (wm * 64 + r) * 128, boff = (wn * 64 + r) * 128;
  const int sw0 = ((q) ^ (r & 7)) * 16, sw1 = ((4 + q) ^ (r & 7)) * 16;
#define G_LOAD(RA, RB, KT) _Pragma("unroll") for (int i = 0; i < 4; ++i) { \
    RA[i] = (!NULLCHK || ((amask >> i) & 1u)) ? *(const u32x4*)(a0 + i * astr + (KT) * 64) : z4; \
    RB[i] = *(const u32x4*)(b0 + i * bstr + (KT) * 64); }
#define G_STORE(RA, RB) _Pragma("unroll") for (int i = 0; i < 4; ++i) { \
    *(u32x4*)(As + soff + i * 4096) = RA[i]; \
    *(u32x4*)(Bs + soff + i * 4096) = RB[i]; }
#define G_COMPUTE() _Pragma("unroll") for (int ks = 0; ks < 2; ++ks) { \
    bf16x8 af[4], bfr[4]; \
    _Pragma("unroll") for (int mi = 0; mi < 4; ++mi) af[mi] = *(const bf16x8*)(As + aoff + mi * 2048 + (ks ? sw1 : sw0)); \
    _Pragma("unroll") for (int ni = 0; ni < 4; ++ni) bfr[ni] = *(const bf16x8*)(Bs + boff + ni * 2048 + (ks ? sw1 : sw0)); \
    __builtin_amdgcn_s_setprio(1); \
    _Pragma("unroll") for (int mi = 0; mi < 4; ++mi) _Pragma("unroll") for (int ni = 0; ni < 4; ++ni) acc[mi][ni] = mfma16(bfr[ni], af[mi], acc[mi][ni]); \
    __builtin_amdgcn_s_setprio(0); }
  G_LOAD(ra0, rb0, 0)
#pragma unroll
  for (int mi = 0; mi < 4; ++mi)
#pragma unroll
    for (int ni = 0; ni < 4; ++ni) acc[mi][ni] = f32x4{0.f, 0.f, 0.f, 0.f};
  for (int kt = 0; kt < nk; ++kt) {
    if (kt == 0) __syncthreads(); else lds_barrier();
    G_STORE(ra0, rb0)
    lds_barrier();
    if (PMODE != 1 && kt + 1 < nk) { G_LOAD(ra0, rb0, kt + 1) }
    __builtin_amdgcn_sched_barrier(0);
    G_COMPUTE()
  }
#undef G_LOAD
#undef G_STORE
#undef G_COMPUTE
}

template <int PMODE = 0>
DI void gemm_std(const bf16_t* A, int lda, int m0, const bf16_t* Bt, int ldb, int n0, int nk, f32x4 (&acc)[4][4], char* smem) {
  const int t = threadIdx.x;
  const bf16_t* a0 = A + (size_t)(m0 + (t >> 3)) * lda + (t & 7) * 8;
  const bf16_t* b0 = Bt + (size_t)(n0 + (t >> 3)) * ldb + (t & 7) * 8;
  gemm_main<false, PMODE>(a0, (size_t)32 * lda, 0xfu, b0, (size_t)32 * ldb, nk, acc, smem);
}

DI bool get_tile(int vb, int step, int MT, int NT, int GW, int& mt, int& nt, bool& valid) {
  const int G = gridDim.x;
  if ((G & 7) == 0 && ((G >> 3) % GW) == 0) {
    const int xcd = vb & 7, local = vb >> 3, GH = (G >> 3) / GW;
    const int NGN = (NT + GW - 1) / GW, NGM = (MT + GH - 1) / GH;
    const int g = step * 8 + xcd;
    if (g >= NGN * NGM) return false;
    mt = (g / NGN) * GH + local / GW; nt = (g % NGN) * GW + local % GW;
    valid = mt < MT && nt < NT;
    return true;
  }
  const int idx = vb + step * G;
  if (idx >= MT * NT) return false;
  mt = idx / NT; nt = idx % NT; valid = true;
  return true;
}

DI bool get_tile_strip(int vb, int step, int MT, int NT, int GW, int& mt, int& nt) {
  const int G = gridDim.x, T = MT * NT;
  int idx;
  if ((G & 7) == 0) {
    const int xcd = vb & 7, local = vb >> 3, lpx = G >> 3;
    const int start = (int)(((long)T * xcd) >> 3), end = (int)(((long)T * (xcd + 1)) >> 3);
    idx = start + local + lpx * step;
    if (idx >= end) return false;
  } else {
    idx = vb + step * G;
    if (idx >= T) return false;
  }
  const int strip = idx / (MT * GW), rem = idx % (MT * GW);
  mt = rem / GW; nt = strip * GW + rem % GW;
  return true;
}

#define EPI_COORDS const int t = threadIdx.x, lane = t & 63, w = t >> 6, wm = w >> 1, wn = w & 1, r = lane & 15, q = lane >> 4; (void)wm; (void)wn; (void)r; (void)q;

DI void sample_splitk_task(float* obase, int ldo, const bf16_t* A, int lda, const bf16_t* Bt, int ldb, int nt, int ks, char* smem) {
  f32x4 acc[4][4];
  gemm_std(A + (size_t)ks * 256, lda, NTOK, Bt + (size_t)ks * 256, ldb, nt * 128, 4, acc, smem);
  EPI_COORDS
#pragma unroll
  for (int mi = 0; mi < 4; ++mi)
#pragma unroll
    for (int ni = 0; ni < 4; ++ni) {
      float* o = obase + (size_t)(wm * 64 + mi * 16 + r) * ldo + nt * 128 + wn * 64 + ni * 16 + q * 4;
#pragma unroll
      for (int j = 0; j < 4; ++j) unsafeAtomicAdd(o + j, acc[mi][ni][j]);
    }
}

#ifndef REP_MODE
#define REP_MODE 0
#endif
template <int PMODE>
DI void phase1(const Params& p, char* smem, int vb) {
  constexpr int NT = 20, MT = 128;
  if (PMODE == 0 && vb < 80) sample_splitk_task(p.sproj, NPROJ, p.XN, 1024, p.WinT, 1024, vb % 20, vb / 20, smem);
  for (int step = 0;; ++step) {
    int mt, nt;
    if (!get_tile_strip(vb, step, MT, NT, 4, mt, nt)) break;
    f32x4 acc[4][4];
    if (PMODE == 2) gemm_std<0>(p.XN, 1024, 0, p.WinT, 1024, 0, 16, acc, smem);
    else gemm_std<PMODE>(p.XN, 1024, mt * 128, p.WinT, 1024, nt * 128, 16, acc, smem);
    if (PMODE != 0 && p.ctr[40] == 0) continue;
    EPI_COORDS
#pragma unroll
    for (int mi = 0; mi < 4; ++mi)
#pragma unroll
      for (int ni = 0; ni < 4; ++ni) {
        const int row = mt * 128 + wm * 64 + mi * 16 + r, col = nt * 128 + wn * 64 + ni * 16 + q * 4;
        uint2 pk; pk.x = pack2(acc[mi][ni][0], acc[mi][ni][1]); pk.y = pack2(acc[mi][ni][2], acc[mi][ni][3]);
        *(uint2*)(p.PROJ + (size_t)row * NPROJ + col) = pk;
      }
  }
}

DI void s5_disc(const Params& p, int g, int n, float& abr, float& abi, float& fre, float& fim) {
  const float ar = p.a_re[g * 64 + n], ai = p.a_im[g * 64 + n], dt = expf(p.log_dt[g]);
  const float mag = expf(ar * dt);
  float sn, cs; sincosf(ai * dt, &sn, &cs);
  abr = mag * cs; abi = mag * sn;
  const float den = ar * ar + ai * ai, pp = abr - 1.f;
  fre = (pp * ar + abi * ai) / den; fim = (abi * ar - pp * ai) / den;
}

__device__ void s5_scan_item(const Params& p, int item, char* smem) {
  const int b = item >> 5, g = item & 31;
  float* Xs = (float*)smem;
  bf16_t* Hs = (bf16_t*)(smem + 32768);
  bf16_t* Us = (bf16_t*)(smem + 32768 + 17408);
  const int t = threadIdx.x, lane = t & 63, w = t >> 6, r = lane & 15, q = lane >> 4;
  for (int i = t; i < 64 * 40; i += 256) Us[i] = 0;
  bf16x8 bfrag[2];
#pragma unroll
  for (int x = 0; x < 2; ++x) {
    const int np = (2 * w + x) * 16 + r, n = np >> 1, part = np & 1;
    float abr, abi, fre, fim; s5_disc(p, g, n, abr, abi, fre, fim);
#pragma unroll
    for (int jj = 0; jj < 8; ++jj) {
      float val = 0.f;
      if (q < 2) {
        const int c = q * 8 + jj;
        const float br = p.b_re[(size_t)(g * 64 + n) * 16 + c], bi = p.b_im[(size_t)(g * 64 + n) * 16 + c];
        val = part == 0 ? fre * br - fim * bi : fre * bi + fim * br;
      }
      bfrag[x][jj] = (short)f2bf(val);
    }
  }
  bf16x8 cfrag[4];
#pragma unroll
  for (int ks = 0; ks < 4; ++ks)
#pragma unroll
    for (int jj = 0; jj < 8; ++jj) {
      const int k = ks * 32 + q * 8 + jj;
      const float val = (k & 1) == 0 ? p.c_re[(size_t)(g * 16 + r) * 64 + (k >> 1)] : -p.c_im[(size_t)(g * 16 + r) * 64 + (k >> 1)];
      cfrag[ks][jj] = (short)f2bf(val);
    }
  float abr, abi, hr = 0.f, hi = 0.f;
  { float fre, fim; s5_disc(p, g, lane, abr, abi, fre, fim); }
  const float4 dco = *(const float4*)(p.s5_d + g * 16 + q * 4);
  __syncthreads();
  u32x4 unext = u32x4{0u, 0u, 0u, 0u};
  if (t < 128) unext = *(const u32x4*)(p.PROJ + ((size_t)b * 2048 + (t >> 1)) * NPROJ + g * 16 + (t & 1) * 8);
  for (int ch = 0; ch < 32; ++ch) {
    const size_t tok0 = (size_t)b * 2048 + ch * 64;
    if (t < 128) {
      *(u32x4*)(Us + (t >> 1) * 40 + (t & 1) * 8) = unext;
      if (ch + 1 < 32) unext = *(const u32x4*)(p.PROJ + (tok0 + 64 + (t >> 1)) * NPROJ + g * 16 + (t & 1) * 8);
    }
    lds_barrier();
    {
      bf16x8 af[4];
#pragma unroll
      for (int mt = 0; mt < 4; ++mt) af[mt] = *(const bf16x8*)(Us + (mt * 16 + r) * 40 + q * 8);
#pragma unroll
      for (int x = 0; x < 2; ++x)
#pragma unroll
        for (int mt = 0; mt < 4; ++mt) {
          f32x4 z = f32x4{0.f, 0.f, 0.f, 0.f};
          z = mfma16(af[mt], bfrag[x], z);
          const int col = (2 * w + x) * 16 + r;
#pragma unroll
          for (int j = 0; j < 4; ++j) Xs[(mt * 16 + q * 4 + j) * 128 + col] = z[j];
        }
    }
    lds_barrier();
    if (w == 0) {
      for (int tb = 0; tb < 8; ++tb) {
        f32x2_t xv[8];
#pragma unroll
        for (int u = 0; u < 8; ++u) xv[u] = *(const f32x2_t*)(Xs + (tb * 8 + u) * 128 + 2 * lane);
#pragma unroll
        for (int u = 0; u < 8; ++u) {
          const float nr = abr * hr - abi * hi + xv[u][0], ni = abr * hi + abi * hr + xv[u][1];
          hr = nr; hi = ni;
          *(unsigned*)(Hs + (tb * 8 + u) * 136 + 2 * lane) = pack2(hr, hi);
        }
      }
    }
    lds_barrier();
    {
      f32x4 y = f32x4{0.f, 0.f, 0.f, 0.f};
#pragma unroll
      for (int ks = 0; ks < 4; ++ks) { const bf16x8 a = *(const bf16x8*)(Hs + (w * 16 + r) * 136 + ks * 32 + q * 8); y = mfma16(cfrag[ks], a, y); }
      const int tk = w * 16 + r;
      const uint2 ur = *(const uint2*)(Us + tk * 40 + q * 4);
      const float o0 = geluf_(y[0] + dco.x * bflo(ur.x)), o1 = geluf_(y[1] + dco.y * bfhi(ur.x));
      const float o2 = geluf_(y[2] + dco.z * bflo(ur.y)), o3 = geluf_(y[3] + dco.w * bfhi(ur.y));
      uint2 pk; pk.x = pack2(o0, o1); pk.y = pack2(o2, o3);
      *(uint2*)(p.ys5 + (tok0 + tk) * 512 + g * 16 + q * 4) = pk;
    }
    lds_barrier();
  }
  if (w == 0) { p.p_s5_re[(size_t)(b * 32 + g) * 64 + lane] = hr; p.p_s5_im[(size_t)(b * 32 + g) * 64 + lane] = hi; }
}

__device__ void s5_decode_item(const Params& p, int s, char* smem) {
  float* us = (float*)smem; float* hre = us + 512; float* him = hre + 2048;
  const int t = threadIdx.x; const size_t row = NTOK + s;
  __syncthreads();
  for (int i = t; i < 512; i += 256) us[i] = p.sproj[(size_t)s * NPROJ + i];
  __syncthreads();
  for (int gq = 0; gq < 8; ++gq) {
    const int g = gq * 4 + (t >> 6), n = t & 63;
    float abr, abi, fre, fim; s5_disc(p, g, n, abr, abi, fre, fim);
    const float* br = p.b_re + (size_t)(g * 64 + n) * 16; const float* bi = p.b_im + (size_t)(g * 64 + n) * 16;
    float bur = 0.f, bui = 0.f;
#pragma unroll
    for (int c = 0; c < 16; ++c) { const float u = us[g * 16 + c]; bur += br[c] * u; bui += bi[c] * u; }
    const float xr = fre * bur - fim * bui, xi = fre * bui + fim * bur;
    const size_t si = (size_t)(s * 32 + g) * 64 + n;
    const float h0r = p.st_s5_re[si], h0i = p.st_s5_im[si];
    const float hr = abr * h0r - abi * h0i + xr, hi = abr * h0i + abi * h0r + xi;
    p.s_s5_re[si] = hr; p.s_s5_im[si] = hi;
    hre[g * 64 + n] = hr; him[g * 64 + n] = hi;
  }
  __syncthreads();
  for (int o = t; o < 512; o += 256) {
    const int g = o >> 4;
    const float* cr = p.c_re + (size_t)o * 64; const float* ci = p.c_im + (size_t)o * 64;
    float y = 0.f;
    for (int n = 0; n < 64; ++n) y += cr[n] * hre[g * 64 + n] - ci[n] * him[g * 64 + n];
    y += p.s5_d[o] * us[o];
    p.ys5[row * 512 + o] = f2bf(geluf_(y));
  }
  __syncthreads();
}

__device__ void gdn_prep_item(const Params& p, int item, char* smem) {
  const int c = item & 31, h = (item >> 5) & 3, b = item >> 7;
  bf16_t* Kn = (bf16_t*)smem;
  bf16_t* Qn = (bf16_t*)(smem + 16384);
  float* Lm = (float*)(smem + 16384);
  bf16_t* Vs = (bf16_t*)(smem + 32768);
  float* gcs = (float*)(smem + 49152);
  float* bts = gcs + 64;
  float* egs = bts + 64;
  const int t = threadIdx.x, lane = t & 63, w = t >> 6, r = lane & 15, q = lane >> 4;
  const int tok0 = c * 64; const size_t row0 = (size_t)b * 2048 + tok0;
  bf16_t* gi = p.GDNI + (size_t)item * 36864;
  __syncthreads();
  if (w == 0) {
    const float* bar = p.ba + (row0 + lane) * 8;
    const float beta = sigmoidf_(bar[h]);
    const float xx = bar[4 + h] + p.dt_bias[h];
    const float sp = fmaxf(xx, 0.f) + log1pf(expf(-fabsf(xx)));
    float s = -expf(p.a_log[h]) * sp;
    for (int o = 1; o < 64; o <<= 1) { const float y = __shfl_up(s, o); if (lane >= o) s += y; }
    gcs[lane] = s; bts[lane] = beta; egs[lane] = expf(s);
  }
  __syncthreads();
  if (c == 31) {
    for (int idx = t; idx < 1152; idx += 256) {
      const int i = idx / 384, rem = idx % 384, X = rem >> 7, cc = rem & 127;
      const int col = X * 512 + h * 128 + cc;
      p.p_gdn_conv[(size_t)(b * 3 + i) * 1536 + col] = bf2f(p.PROJ[((size_t)b * 2048 + 2045 + i) * NPROJ + 512 + col]);
    }
  }
  {
    const int row = t >> 2, seg = t & 3;
    const float eg = egs[row], ekg = expf(gcs[63] - gcs[row]);
    const int tok = tok0 + row;
#pragma unroll
    for (int X = 0; X < 3; ++X) {
      float val[32]; float ss = 0.f;
      const int colbase = X * 512 + h * 128 + seg * 32;
#pragma unroll
      for (int cb = 0; cb < 4; ++cb) {
        float a8[8];
#pragma unroll
        for (int e = 0; e < 8; ++e) a8[e] = 0.f;
#pragma unroll
        for (int tap = 0; tap < 4; ++tap) {
          const int tk = tok - 3 + tap;
          if (tk >= 0) {
            const uint4 raw = *(const uint4*)(p.PROJ + ((size_t)b * 2048 + tk) * NPROJ + 512 + colbase + cb * 8);
            const float* wp = p.gdn_conv_w + tap * 1536 + colbase + cb * 8;
            const float4 w0 = *(const float4*)wp, w1 = *(const float4*)(wp + 4);
            a8[0] += bflo(raw.x) * w0.x; a8[1] += bfhi(raw.x) * w0.y; a8[2] += bflo(raw.y) * w0.z; a8[3] += bfhi(raw.y) * w0.w;
            a8[4] += bflo(raw.z) * w1.x; a8[5] += bfhi(raw.z) * w1.y; a8[6] += bflo(raw.w) * w1.z; a8[7] += bfhi(raw.w) * w1.w;
          }
        }
#pragma unroll
        for (int e = 0; e < 8; ++e) { const float v = siluf_(a8[e]); val[cb * 8 + e] = v; ss += v * v; }
        __builtin_amdgcn_sched_barrier(0);
      }
      if (X < 2) {
        ss += __shfl_xor(ss, 1); ss += __shfl_xor(ss, 2);
        const float sc = rsqrtf(ss + 1e-6f) * (X == 0 ? 0.08838834764831845f : 1.f);
#pragma unroll
        for (int e = 0; e < 32; ++e) val[e] *= sc;
      }
      if (X == 0) {
#pragma unroll
        for (int cb = 0; cb < 4; ++cb) {
          uint4 pk; pk.x = pack2(val[cb * 8], val[cb * 8 + 1]); pk.y = pack2(val[cb * 8 + 2], val[cb * 8 + 3]); pk.z = pack2(val[cb * 8 + 4], val[cb * 8 + 5]); pk.w = pack2(val[cb * 8 + 6], val[cb * 8 + 7]);
          *(uint4*)(Qn + row * 128 + (((seg * 4 + cb) ^ (row & 15)) * 8)) = pk;
          uint4 pg; pg.x = pack2(val[cb * 8] * eg, val[cb * 8 + 1] * eg); pg.y = pack2(val[cb * 8 + 2] * eg, val[cb * 8 + 3] * eg); pg.z = pack2(val[cb * 8 + 4] * eg, val[cb * 8 + 5] * eg); pg.w = pack2(val[cb * 8 + 6] * eg, val[cb * 8 + 7] * eg);
          *(uint4*)(gi + 16384 + row * 128 + seg * 32 + cb * 8) = pg;
        }
      } else if (X == 1) {
#pragma unroll
        for (int cb = 0; cb < 4; ++cb) {
          uint4 pk; pk.x = pack2(val[cb * 8], val[cb * 8 + 1]); pk.y = pack2(val[cb * 8 + 2], val[cb * 8 + 3]); pk.z = pack2(val[cb * 8 + 4], val[cb * 8 + 5]); pk.w = pack2(val[cb * 8 + 6], val[cb * 8 + 7]);
          *(uint4*)(Kn + row * 128 + (((seg * 4 + cb) ^ (row & 15)) * 8)) = pk;
        }
#pragma unroll
        for (int e = 0; e < 32; ++e) gi[24576 + (seg * 32 + e) * 64 + row] = f2bf(val[e] * ekg);
      } else {
#pragma unroll
        for (int cb = 0; cb < 4; ++cb) {
          uint4 pk; pk.x = pack2(val[cb * 8], val[cb * 8 + 1]); pk.y = pack2(val[cb * 8 + 2], val[cb * 8 + 3]); pk.z = pack2(val[cb * 8 + 4], val[cb * 8 + 5]); pk.w = pack2(val[cb * 8 + 6], val[cb * 8 + 7]);
          *(uint4*)(Vs + row * 128 + seg * 32 + cb * 8) = pk;
        }
      }
    }
  }
  __syncthreads();
  f32x4 kk[4], qk[4];
  {
    bf16x8 ak[4], aq[4];
    const int rowA = w * 16 + r;
#pragma unroll
    for (int ks = 0; ks < 4; ++ks) { const int phys = (ks * 4 + q) ^ r; ak[ks] = *(const bf16x8*)(Kn + rowA * 128 + phys * 8); aq[ks] = *(const bf16x8*)(Qn + rowA * 128 + phys * 8); }
#pragma unroll
    for (int nt = 0; nt < 4; ++nt) {
      kk[nt] = f32x4{0.f, 0.f, 0.f, 0.f}; qk[nt] = f32x4{0.f, 0.f, 0.f, 0.f};
      if (nt <= w) {
        const int rowB = nt * 16 + r;
#pragma unroll
        for (int ks = 0; ks < 4; ++ks) {
          const int phys = (ks * 4 + q) ^ r;
          const bf16x8 bb = *(const bf16x8*)(Kn + rowB * 128 + phys * 8);
          kk[nt] = mfma16(ak[ks], bb, kk[nt]); qk[nt] = mfma16(aq[ks], bb, qk[nt]);
        }
      }
    }
  }
  __syncthreads();
#pragma unroll
  for (int nt = 0; nt < 4; ++nt)
#pragma unroll
    for (int j = 0; j < 4; ++j) {
      const int i = w * 16 + q * 4 + j, jc = nt * 16 + r;
      const float dec = __expf(fminf(gcs[i] - gcs[jc], 0.f));
      Lm[i * 64 + jc] = (i > jc) ? bts[i] * kk[nt][j] * dec : 0.f;
      gi[32768 + i * 64 + jc] = f2bf((i >= jc) ? qk[nt][j] * dec : 0.f);
    }
  __syncthreads();
  {
    float sol[64];
    const bool isv = t < 128;
    const int kc = t - 128;
    if (isv) {
#pragma unroll
      for (int i = 0; i < 64; ++i) { sol[i] = bf2f(Vs[i * 128 + t]) * bts[i]; if ((i & 7) == 7) __builtin_amdgcn_sched_barrier(0); }
    } else {
#pragma unroll
      for (int i = 0; i < 64; ++i) { sol[i] = bf2f(Kn[i * 128 + (((kc >> 3) ^ (i & 15)) * 8) + (kc & 7)]) * bts[i] * egs[i]; if ((i & 7) == 7) __builtin_amdgcn_sched_barrier(0); }
    }
    __builtin_amdgcn_sched_barrier(0);
#pragma unroll
    for (int i = 1; i < 64; ++i) {
      float a = sol[i];
#pragma unroll
      for (int jb = 0; jb < (i + 3) / 4; ++jb) {
        const float4 l = *(const float4*)(Lm + i * 64 + jb * 4);
        if (jb * 4 + 0 < i) a -= l.x * sol[jb * 4 + 0];
        if (jb * 4 + 1 < i) a -= l.y * sol[jb * 4 + 1];
        if (jb * 4 + 2 < i) a -= l.z * sol[jb * 4 + 2];
        if (jb * 4 + 3 < i) a -= l.w * sol[jb * 4 + 3];
      }
      sol[i] = a;
      if ((i & 1) == 0) __builtin_amdgcn_sched_barrier(0);
    }
    bf16_t* go = gi + t + (isv ? 0 : 8192 - 128);
#pragma unroll
    for (int i = 0; i < 64; ++i) { go[i * 128] = f2bf(sol[i]); if ((i & 7) == 7) __builtin_amdgcn_sched_barrier(0); }
  }
  if (t == 0) p.glast[item] = egs[63];
}

__device__ void gdn_decode_item(const Params& p, int item, char* smem) {
  const int h = item & 3, s = item >> 2; const size_t row = NTOK + s;
  float* qs = (float*)smem; float* ks = qs + 128; float* vs = ks + 128; float* part = vs + 128; float* red = part + 512;
  const int t = threadIdx.x;
  __syncthreads();
  float cv[3] = {0.f, 0.f, 0.f};
  if (t < 128) {
#pragma unroll
    for (int X = 0; X < 3; ++X) {
      const int col = X * 512 + h * 128 + t;
      const float* buf = p.st_gdn_conv + (size_t)s * 3 * 1536 + col;
      const float b0 = buf[0], b1 = buf[1536], b2 = buf[3072];
      const float nw = p.sproj[(size_t)s * NPROJ + 512 + col];
      const float* cw = p.gdn_conv_w + col;
      const float a = b0 * cw[0] + b1 * cw[1536] + b2 * cw[3072] + nw * cw[4608];
      cv[X] = siluf_(a);
      float* ob = p.s_gdn_conv + (size_t)s * 3 * 1536 + col;
      ob[0] = b1; ob[1536] = b2; ob[3072] = nw;
    }
  }
  const float sq = block_sum(cv[0] * cv[0], red), sk = block_sum(cv[1] * cv[1], red);
  const float qn = cv[0] * rsqrtf(sq + 1e-6f) * 0.08838834764831845f, kn = cv[1] * rsqrtf(sk + 1e-6f);
  const float qk = block_sum(qn * kn, red);
  if (t < 128) { qs[t] = qn; ks[t] = kn; vs[t] = cv[2]; }
  const float beta = sigmoidf_(p.ba[row * 8 + h]);
  const float xx = p.ba[row * 8 + 4 + h] + p.dt_bias[h];
  const float eg = expf(-expf(p.a_log[h]) * (fmaxf(xx, 0.f) + log1pf(expf(-fabsf(xx)))));
  __syncthreads();
  const int e = t & 127, dh = t >> 7;
  const size_t soff = ((size_t)(s * 4 + h) * 128 + dh * 64) * 128 + e;
  const float* S0 = p.st_gdn + soff;
  float sr[64]; float kS = 0.f, qS = 0.f;
#pragma unroll
  for (int d = 0; d < 64; ++d) { sr[d] = S0[(size_t)d * 128]; kS += ks[dh * 64 + d] * sr[d]; qS += qs[dh * 64 + d] * sr[d]; }
  part[dh * 128 + e] = kS; part[256 + dh * 128 + e] = qS;
  __syncthreads();
  kS = part[e] + part[128 + e]; qS = part[256 + e] + part[384 + e];
  const float vn = beta * (vs[e] - eg * kS);
  const float o = eg * qS + qk * vn;
  float* S1 = p.s_gdn + soff;
#pragma unroll
  for (int d = 0; d < 64; ++d) S1[(size_t)d * 128] = sr[d] * eg + ks[dh * 64 + d] * vn;
  const float so = block_sum(dh == 0 ? o * o : 0.f, red);
  if (dh == 0) {
    const float z = p.sproj[(size_t)s * NPROJ + 2048 + h * 128 + e];
    p.XN[row * 1024 + 512 + h * 128 + e] = f2bf(o * rsqrtf(so * (1.f / 128.f) + 1e-6f) * p.onorm_g[e] * siluf_(z));
  }
  __syncthreads();
}

#ifndef REP_MASK
#define REP_MASK 15
#endif
template <int MASK>
DI void phase2(const Params& p, char* smem, int cofs) {
  constexpr int N_S5 = 256, N_PREP = 1024, N_SDEC = 128;
  for (;;) {
    int it = fetch_item(p.ctr + 2 + cofs);
    if (it >= N_S5 + N_PREP + N_SDEC) break;
    if (it < N_S5) { if (MASK & 1) s5_scan_item(p, it, smem); continue; }
    it -= N_S5;
    if (it < N_PREP) { if (MASK & 2) gdn_prep_item(p, it, smem); continue; }
    it -= N_PREP;
    if (MASK & 8) s5_decode_item(p, it, smem);
  }
}

__device__ void gdn_seq_item(const Params& p, int item, char* smem) {
  const int sl = item & 3, h = (item >> 2) & 3, b = item >> 4;
  bf16_t* ST = (bf16_t*)smem;
  bf16_t* VT = (bf16_t*)(smem + 8704);
  const int t = threadIdx.x, lane = t & 63, w = t >> 6, r = lane & 15, q = lane >> 4;
  __syncthreads();
  for (int i = t; i < 32 * 136; i += 256) ST[i] = 0;
  f32x4 sacc[2][2];
#pragma unroll
  for (int mi = 0; mi < 2; ++mi)
#pragma unroll
    for (int ni = 0; ni < 2; ++ni) sacc[mi][ni] = f32x4{0.f, 0.f, 0.f, 0.f};
  bf16x8 W0[4], Q0[4], A0[2], K0[2][2];
  unsigned U0[2][4]; float g0;
  const bf16_t* gbase = p.GDNI + (size_t)((b * 4 + h) * 32) * 36864;
  const float* glb = p.glast + (b * 4 + h) * 32;
#define SEQ_LOAD_WQU(S, C) { \
    const bf16_t* gi_ = gbase + (size_t)(C) * 36864; \
    _Pragma("unroll") for (int ks = 0; ks < 4; ++ks) { \
      W##S[ks] = *(const bf16x8*)(gi_ + 8192 + (w * 16 + r) * 128 + ks * 32 + q * 8); \
      Q##S[ks] = *(const bf16x8*)(gi_ + 16384 + (w * 16 + r) * 128 + ks * 32 + q * 8); } \
    _Pragma("unroll") for (int ni = 0; ni < 2; ++ni) _Pragma("unroll") for (int j = 0; j < 4; ++j) \
      U##S[ni][j] = (unsigned)gi_[(w * 16 + q * 4 + j) * 128 + sl * 32 + ni * 16 + r]; \
    g##S = glb[(C)]; }
#define SEQ_LOAD_AK(S, C) { \
    const bf16_t* gi_ = gbase + (size_t)(C) * 36864; \
    _Pragma("unroll") for (int k2 = 0; k2 < 2; ++k2) { \
      A##S[k2] = *(const bf16x8*)(gi_ + 32768 + (w * 16 + r) * 64 + k2 * 32 + q * 8); \
      _Pragma("unroll") for (int mi = 0; mi < 2; ++mi) K##S[mi][k2] = *(const bf16x8*)(gi_ + 24576 + ((2 * w + mi) * 16 + r) * 64 + k2 * 32 + q * 8); } }
#define SEQ_CHUNK(S, C) { \
    f32x4 vacc[2], oacc[2]; \
    _Pragma("unroll") for (int ni = 0; ni < 2; ++ni) { vacc[ni] = f32x4{0.f, 0.f, 0.f, 0.f}; oacc[ni] = f32x4{0.f, 0.f, 0.f, 0.f}; } \
    _Pragma("unroll") for (int ks = 0; ks < 4; ++ks) { \
      _Pragma("unroll") for (int ni = 0; ni < 2; ++ni) { \
        const bf16x8 bs = *(const bf16x8*)(ST + (ni * 16 + r) * 136 + ks * 32 + q * 8); \
        vacc[ni] = mfma16(W0[ks], bs, vacc[ni]); oacc[ni] = mfma16(bs, Q0[ks], oacc[ni]); } } \
    _Pragma("unroll") for (int ni = 0; ni < 2; ++ni) { \
      float vn[4]; \
      _Pragma("unroll") for (int j = 0; j < 4; ++j) vn[j] = __uint_as_float(U0[ni][j] << 16) - vacc[ni][j]; \
      uint2 pk; pk.x = pack2(vn[0], vn[1]); pk.y = pack2(vn[2], vn[3]); \
      *(uint2*)(VT + (ni * 16 + r) * 72 + w * 16 + q * 4) = pk; } \
    const float gl = g0; \
    __builtin_amdgcn_sched_barrier(0); \
    if ((C) + 1 < 32) SEQ_LOAD_WQU(0, (C) + 1) \
    __builtin_amdgcn_sched_barrier(0); \
    lds_barrier(); \
    bf16x8 bv[2][2]; \
    _Pragma("unroll") for (int ni = 0; ni < 2; ++ni) _Pragma("unroll") for (int k2 = 0; k2 < 2; ++k2) bv[ni][k2] = *(const bf16x8*)(VT + (ni * 16 + r) * 72 + k2 * 32 + q * 8); \
    _Pragma("unroll") for (int k2 = 0; k2 < 2; ++k2) _Pragma("unroll") for (int ni = 0; ni < 2; ++ni) oacc[ni] = mfma16(bv[ni][k2], A0[k2], oacc[ni]); \
    _Pragma("unroll") for (int mi = 0; mi < 2; ++mi) { \
      _Pragma("unroll") for (int ni = 0; ni < 2; ++ni) sacc[mi][ni] *= gl; \
      _Pragma("unroll") for (int k2 = 0; k2 < 2; ++k2) _Pragma("unroll") for (int ni = 0; ni < 2; ++ni) sacc[mi][ni] = mfma16(K0[mi][k2], bv[ni][k2], sacc[mi][ni]); } \
    __builtin_amdgcn_sched_barrier(0); \
    if ((C) + 1 < 32) SEQ_LOAD_AK(0, (C) + 1) \
    __builtin_amdgcn_sched_barrier(0); \
    _Pragma("unroll") for (int ni = 0; ni < 2; ++ni) { \
      float4 o; o.x = oacc[ni][0]; o.y = oacc[ni][1]; o.z = oacc[ni][2]; o.w = oacc[ni][3]; \
      *(float4*)(p.ogdn + ((size_t)b * 2048 + (C) * 64 + w * 16 + r) * 512 + h * 128 + sl * 32 + ni * 16 + q * 4) = o; } \
    _Pragma("unroll") for (int mi = 0; mi < 2; ++mi) _Pragma("unroll") for (int ni = 0; ni < 2; ++ni) { \
      uint2 pk; pk.x = pack2(sacc[mi][ni][0], sacc[mi][ni][1]); pk.y = pack2(sacc[mi][ni][2], sacc[mi][ni][3]); \
      *(uint2*)(ST + (ni * 16 + r) * 136 + (2 * w + mi) * 16 + q * 4) = pk; } \
    lds_barrier(); }
  SEQ_LOAD_WQU(0, 0)
  SEQ_LOAD_AK(0, 0)
  __syncthreads();
  for (int c = 0; c < 32; c += 2) {
    SEQ_CHUNK(0, c)
    SEQ_CHUNK(1, c + 1)
  }
#undef SEQ_LOAD_WQU
#undef SEQ_LOAD_AK
#undef SEQ_CHUNK
#pragma unroll
  for (int mi = 0; mi < 2; ++mi)
#pragma unroll
    for (int ni = 0; ni < 2; ++ni)
#pragma unroll
      for (int j = 0; j < 4; ++j)
        p.p_gdn[((size_t)(b * 4 + h) * 128 + (2 * w + mi) * 16 + q * 4 + j) * 128 + sl * 32 + ni * 16 + r] = sacc[mi][ni][j];
}

__device__ void glu_tile(const Params& p, int idx, char* smem) {
  const int mt = idx >> 3, nt = idx & 7;
  f32x4 acc[4][4];
  gemm_std(p.ys5, 512, mt * 128, p.WgluT, 512, nt * 128, 8, acc, smem);
  EPI_COORDS
#pragma unroll
  for (int mi = 0; mi < 4; ++mi)
#pragma unroll
    for (int ni = 0; ni < 2; ++ni) {
      const int row = mt * 128 + wm * 64 + mi * 16 + r, col = nt * 64 + wn * 32 + ni * 16 + q * 4;
      float o[4];
#pragma unroll
      for (int j = 0; j < 4; ++j) o[j] = acc[mi][ni][j] * sigmoidf_(acc[mi][ni + 2][j]);
      uint2 pk; pk.x = pack2(o[0], o[1]); pk.y = pack2(o[2], o[3]);
      *(uint2*)(p.XN + (size_t)row * 1024 + col) = pk;
    }
}

template <int MASK>
DI void phase3(const Params& p, char* smem, int cofs) {
  constexpr int N_SEQ = 128, N_GLU = 129 * 8, N_GDEC = 512;
  for (;;) {
    int it = fetch_item(p.ctr + 3 + cofs);
    if (it >= N_SEQ + N_GLU + N_GDEC) break;
    if (it < N_SEQ) { if (MASK & 1) gdn_seq_item(p, it, smem); }
    else if (it < N_SEQ + N_GLU) { if (MASK & 2) glu_tile(p, it - N_SEQ, smem); }
    else { if (MASK & 2) gdn_decode_item(p, it - N_SEQ - N_GLU, smem); }
  }
}

__device__ void phase4(const Params& p) {
  const int lane = threadIdx.x & 63, w = threadIdx.x >> 6;
  for (int i = blockIdx.x * 256 + threadIdx.x; i < 128 * 1024 / 4; i += gridDim.x * 256)
    *(float4*)(p.out + (size_t)NTOK * 1024 + (size_t)i * 4) = *(const float4*)(p.x_sample + (size_t)i * 4);
  for (int it = blockIdx.x; it < NTOK / 4; it += gridDim.x) {
    const size_t row = (size_t)it * 4 + w;
    const float* op = p.ogdn + row * 512 + lane * 8;
    const float4 o0 = *(const float4*)op, o1 = *(const float4*)(op + 4);
    float ss = o0.x * o0.x + o0.y * o0.y + o0.z * o0.z + o0.w * o0.w + o1.x * o1.x + o1.y * o1.y + o1.z * o1.z + o1.w * o1.w;
    ss += __shfl_xor(ss, 1); ss += __shfl_xor(ss, 2); ss += __shfl_xor(ss, 4); ss += __shfl_xor(ss, 8);
    const float rs = rsqrtf(ss * (1.f / 128.f) + 1e-6f);
    const uint4 zr = *(const uint4*)(p.PROJ + row * NPROJ + 2048 + lane * 8);
    const float* gp = p.onorm_g + (lane & 15) * 8;
    const float4 g0 = *(const float4*)gp, g1 = *(const float4*)(gp + 4);
    uint4 pk;
    pk.x = pack2(o0.x * rs * g0.x * siluf_(bflo(zr.x)), o0.y * rs * g0.y * siluf_(bfhi(zr.x)));
    pk.y = pack2(o0.z * rs * g0.z * siluf_(bflo(zr.y)), o0.w * rs * g0.w * siluf_(bfhi(zr.y)));
    pk.z = pack2(o1.x * rs * g1.x * siluf_(bflo(zr.z)), o1.y * rs * g1.y * siluf_(bfhi(zr.z)));
    pk.w = pack2(o1.z * rs * g1.z * siluf_(bflo(zr.w)), o1.w * rs * g1.w * siluf_(bfhi(zr.w)));
    *(uint4*)(p.XN + row * 1024 + 512 + lane * 8) = pk;
  }
}

__device__ void phase5(const Params& p, char* smem, int vb) {
  for (int step = 0;; ++step) {
    int mt, nt; bool valid;
    if (!get_tile(vb, step, 128, 8, 8, mt, nt, valid)) break;
    if (!valid) continue;
    f32x4 acc[4][4];
    gemm_std(p.XN, 1024, mt * 128, p.WoutT, 1024, nt * 128, 16, acc, smem);
    EPI_COORDS
#pragma unroll
    for (int mi = 0; mi < 4; ++mi) {
      const int row = mt * 128 + wm * 64 + mi * 16 + r;
      const float* xr = xin_row(p, row);
      float4 xv[4];
#pragma unroll
      for (int ni = 0; ni < 4; ++ni) xv[ni] = *(const float4*)(xr + nt * 128 + wn * 64 + ni * 16 + q * 4);
#pragma unroll
      for (int ni = 0; ni < 4; ++ni) {
        float4 o; o.x = xv[ni].x + acc[mi][ni][0]; o.y = xv[ni].y + acc[mi][ni][1]; o.z = xv[ni].z + acc[mi][ni][2]; o.w = xv[ni].w + acc[mi][ni][3];
        *(float4*)(p.out + (size_t)row * 1024 + nt * 128 + wn * 64 + ni * 16 + q * 4) = o;
      }
    }
  }
  if (vb < 32) sample_splitk_task(p.out + (size_t)NTOK * 1024, 1024, p.XN, 1024, p.WoutT, 1024, vb & 7, vb >> 3, smem);
}

__device__ void phase_norm(const Params& p, bool final_) {
  const int lane = threadIdx.x & 63, w = threadIdx.x >> 6;
  const float* gw = final_ ? p.normf_g : p.norm2_g;
  float4 g[4];
#pragma unroll
  for (int i = 0; i < 4; ++i) g[i] = *(const float4*)(gw + i * 256 + lane * 4);
  for (int it = blockIdx.x; it < MROWS / 8; it += gridDim.x) {
    float4 v[2][4];
#pragma unroll
    for (int rr = 0; rr < 2; ++rr)
#pragma unroll
      for (int i = 0; i < 4; ++i) v[rr][i] = *(const float4*)(p.out + ((size_t)it * 8 + rr * 4 + w) * 1024 + i * 256 + lane * 4);
#pragma unroll
    for (int rr = 0; rr < 2; ++rr) {
      const size_t row = (size_t)it * 8 + rr * 4 + w;
      float* xr = p.out + row * 1024;
      float ss = 0.f;
#pragma unroll
      for (int i = 0; i < 4; ++i) ss += v[rr][i].x * v[rr][i].x + v[rr][i].y * v[rr][i].y + v[rr][i].z * v[rr][i].z + v[rr][i].w * v[rr][i].w;
      ss = wave_sum(ss);
      const float rstd = rsqrtf(ss * (1.f / 1024.f) + 1e-6f);
#pragma unroll
      for (int i = 0; i < 4; ++i) {
        float4 o; o.x = v[rr][i].x * rstd * g[i].x; o.y = v[rr][i].y * rstd * g[i].y; o.z = v[rr][i].z * rstd * g[i].z; o.w = v[rr][i].w * rstd * g[i].w;
        if (final_) *(float4*)(xr + i * 256 + lane * 4) = o;
        else { uint2 pk; pk.x = pack2(o.x, o.y); pk.y = pack2(o.z, o.w); *(uint2*)(p.XN + row * 1024 + i * 256 + lane * 4) = pk; }
      }
    }
  }
}

__device__ void phase7(const Params& p, char* smem, int vb) {
  constexpr int NT = 44, MT = 137;
  float* hl = (float*)smem;
  for (int step = 0;; ++step) {
    int mt, nt;
    if (!get_tile_strip(vb, step, MT, NT, 4, mt, nt)) break;
    const bool samp = mt == 136;
    const int bb = mt / 17, ii = mt % 17;
    f32x4 acc[4][4];
    {
      const int t = threadIdx.x;
      unsigned amask = 0;
      long arow0;
      if (samp) { arow0 = NTOK + (t >> 3); amask = 0xfu; }
      else {
        arow0 = (long)bb * 2048 + 126 * ii - 2 + (t >> 3);
#pragma unroll
        for (int i = 0; i < 4; ++i) { const int tok = 126 * ii - 2 + (t >> 3) + 32 * i; if (tok >= 0 && tok < 2048) amask |= 1u << i; }
      }
      const bf16_t* a0 = p.XN + arow0 * 1024 + (t & 7) * 8;
      const bf16_t* b0 = p.WupT + (size_t)(nt * 128 + (t >> 3)) * 1024 + (t & 7) * 8;
      gemm_main<true>(a0, (size_t)32 * 1024, amask, b0, (size_t)32 * 1024, 16, acc, smem);
    }
    EPI_COORDS
    __syncthreads();
#pragma unroll
    for (int mi = 0; mi < 4; ++mi)
#pragma unroll
      for (int ni = 0; ni < 4; ++ni)
#pragma unroll
        for (int j = 0; j < 4; ++j) hl[(wm * 64 + mi * 16 + r) * 132 + wn * 64 + ni * 16 + q * 4 + j] = acc[mi][ni][j];
    __syncthreads();
    {
      const int jp = t & 31, rbase = (t >> 5) * 16;
      const int hsel = jp >> 4, lc = hsel * 64 + 2 * (jp & 15);
      const int colp = nt * 64 + hsel * 32 + 2 * (jp & 15);
      const float2 wg0 = *(const float2*)(p.ffn_conv_w + colp), wg1 = *(const float2*)(p.ffn_conv_w + 5632 + colp), wg2 = *(const float2*)(p.ffn_conv_w + 2 * 5632 + colp);
      const float2 wu0 = *(const float2*)(p.ffn_conv_w + 2816 + colp), wu1 = *(const float2*)(p.ffn_conv_w + 5632 + 2816 + colp), wu2 = *(const float2*)(p.ffn_conv_w + 2 * 5632 + 2816 + colp);
      if (samp) {
#pragma unroll 2
        for (int rr = 0; rr < 16; ++rr) {
          const int sidx = rbase + rr;
          const float* sb = p.st_ffn_conv + (size_t)sidx * 2 * 5632;
          const float2 g0 = *(const float2*)(sb + colp), g1 = *(const float2*)(sb + 5632 + colp), u0 = *(const float2*)(sb + 2816 + colp), u1 = *(const float2*)(sb + 5632 + 2816 + colp);
          const float2 hg = *(const float2*)(hl + sidx * 132 + lc), hu = *(const float2*)(hl + sidx * 132 + lc + 32);
          const float ga = g0.x * wg0.x + g1.x * wg1.x + hg.x * wg2.x, gb = g0.y * wg0.y + g1.y * wg1.y + hg.y * wg2.y;
          const float ua = u0.x * wu0.x + u1.x * wu1.x + hu.x * wu2.x, ub = u0.y * wu0.y + u1.y * wu1.y + hu.y * wu2.y;
          *(unsigned*)(p.ACT + (size_t)(NTOK + sidx) * 2816 + colp) = pack2(siluf_(ga) * ua, siluf_(gb) * ub);
          float* ob = p.s_ffn_conv + (size_t)sidx * 2 * 5632;
          *(float2*)(ob + colp) = g1; *(float2*)(ob + 2816 + colp) = u1; *(float2*)(ob + 5632 + colp) = hg; *(float2*)(ob + 5632 + 2816 + colp) = hu;
        }
      } else {
        float2 ga = make_float2(0.f, 0.f), gb = ga, ua = ga, ub = ga;
        if (rbase >= 2) {
          ga = *(const float2*)(hl + (rbase - 2) * 132 + lc); gb = *(const float2*)(hl + (rbase - 1) * 132 + lc);
          ua = *(const float2*)(hl + (rbase - 2) * 132 + lc + 32); ub = *(const float2*)(hl + (rbase - 1) * 132 + lc + 32);
        }
#pragma unroll 4
        for (int rr = 0; rr < 16; ++rr) {
          const int rowt = rbase + rr;
          const int tok = 126 * ii - 2 + rowt;
          float2 gc = *(const float2*)(hl + rowt * 132 + lc), uc = *(const float2*)(hl + rowt * 132 + lc + 32);
          if (tok < 0) { gc = make_float2(0.f, 0.f); uc = gc; }
          if (rowt >= 2 && tok < 2048) {
            const float g0 = ga.x * wg0.x + gb.x * wg1.x + gc.x * wg2.x, g1 = ga.y * wg0.y + gb.y * wg1.y + gc.y * wg2.y;
            const float u0 = ua.x * wu0.x + ub.x * wu1.x + uc.x * wu2.x, u1 = ua.y * wu0.y + ub.y * wu1.y + uc.y * wu2.y;
            *(unsigned*)(p.ACT + ((size_t)bb * 2048 + tok) * 2816 + colp) = pack2(siluf_(g0) * u0, siluf_(g1) * u1);
            if (tok >= 2046) {
              float* ob = p.p_ffn_conv + (size_t)(bb * 2 + (tok - 2046)) * 5632;
              *(float2*)(ob + colp) = gc; *(float2*)(ob + 2816 + colp) = uc;
            }
          }
          ga = gb; gb = gc; ua = ub; ub = uc;
        }
      }
    }
  }
}

__device__ void phase8(const Params& p, char* smem, int vb) {
  for (int step = 0;; ++step) {
    int mt, nt; bool valid;
    if (!get_tile(vb, step, 128, 8, 8, mt, nt, valid)) break;
    if (!valid) continue;
    f32x4 acc[4][4];
    gemm_std(p.ACT, 2816, mt * 128, p.WdnT, 2816, nt * 128, 44, acc, smem);
    EPI_COORDS
#pragma unroll
    for (int mi = 0; mi < 4; ++mi) {
      float* orow = p.out + (size_t)(mt * 128 + wm * 64 + mi * 16 + r) * 1024 + nt * 128 + wn * 64 + q * 4;
      float4 xv[4];
#pragma unroll
      for (int ni = 0; ni < 4; ++ni) xv[ni] = *(const float4*)(orow + ni * 16);
#pragma unroll
      for (int ni = 0; ni < 4; ++ni) {
        float4 o; o.x = xv[ni].x + acc[mi][ni][0]; o.y = xv[ni].y + acc[mi][ni][1]; o.z = xv[ni].z + acc[mi][ni][2]; o.w = xv[ni].w + acc[mi][ni][3];
        *(float4*)(orow + ni * 16) = o;
      }
    }
  }
  if (vb < 88) sample_splitk_task(p.out + (size_t)NTOK * 1024, 1024, p.ACT, 2816, p.WdnT, 2816, vb & 7, vb >> 3, smem);
}

template <int PH>
DI void run_phase(const Params& p, char* smem, int vb, int cofs = 0) {
  if (PH == 0) phase0(p, smem);
  else if (PH == 1) { if (cofs) phase1<REP_MODE + 10 * 0>(p, smem, vb); else phase1<0>(p, smem, vb); }
  else if (PH == 2) { if (cofs) phase2<REP_MASK>(p, smem, cofs); else phase2<15>(p, smem, 0); }
  else if (PH == 3) { if (cofs) phase3<(REP_MASK & 3)>(p, smem, cofs); else phase3<3>(p, smem, 0); }
  else if (PH == 4) phase4(p);
  else if (PH == 5) phase5(p, smem, vb);
  else if (PH == 6) phase_norm(p, false);
  else if (PH == 7) phase7(p, smem, vb);
  else if (PH == 8) phase8(p, smem, vb);
  else phase_norm(p, true);
}

template <int PH>
__global__ void __launch_bounds__(256, 2) phase_kernel(Params p) {
  __shared__ __attribute__((aligned(16))) char smem[SMEM_BYTES];
  run_phase<PH>(p, smem, blockIdx.x);
}


#define XB_TMO      128
#define XB_XCNT(j)  (256  + 64 * (j))
#define XB_XSUB(j)  (1280 + 64 * (j))
#define XB_XGEN(j)  (2304 + 64 * (j))
#define XB_TOP      3328
#define XB_TOPGEN   3392
#define XCD_BAR_WORDS 3456
#define XB_SPIN_CAP (1u << 18)
#define LAS __attribute__((address_space(3)))
DI unsigned xb_ld(unsigned* p) { return __hip_atomic_load(p, __ATOMIC_RELAXED, __HIP_MEMORY_SCOPE_AGENT); }
DI unsigned xb_add(unsigned* p, unsigned v) { return __hip_atomic_fetch_add(p, v, __ATOMIC_RELAXED, __HIP_MEMORY_SCOPE_AGENT); }
DI unsigned xb_xcc_id() { return (unsigned)__builtin_amdgcn_s_getreg((3 << 11) | 20) & 0xFu; }
#define XB_SPIN(cond, bar) do { unsigned _sp = 0; while (cond) { __builtin_amdgcn_s_sleep(1); \
    if ((++_sp & 255u) == 0u) { if (xb_ld(&(bar)[XB_TMO])) break; if (_sp > XB_SPIN_CAP) { atomicAdd(&(bar)[XB_TMO], 1u); break; } } } } while (0)
struct XcdBarrier { unsigned* bar; unsigned x; volatile LAS unsigned* st; };
DI XcdBarrier xcd_barrier_post(unsigned* bar, volatile LAS unsigned* st) {
  XcdBarrier b; b.bar = bar; b.x = xb_xcc_id(); b.st = st;
  if (threadIdx.x == 0) (void)xb_add(&bar[XB_XCNT(b.x)], 1u);
  return b;
}
DI void xcd_barrier_complete(unsigned* bar, unsigned x, unsigned& nloc, unsigned& nx) {
  const unsigned G = gridDim.x * gridDim.y * gridDim.z;
  unsigned sum, cnt, mine, sp = 0u;
  for (;;) {
    sum = 0u; cnt = 0u; mine = 0u;
#pragma unroll
    for (unsigned j = 0; j < 16; ++j) { const unsigned c = xb_ld(&bar[XB_XCNT(j)]); sum += c; cnt += (c > 0u) ? 1u : 0u; mine = (j == x) ? c : mine; }
    if (sum == G) break;
    __builtin_amdgcn_s_sleep(1);
    if ((++sp & 255u) == 0u) { if (xb_ld(&bar[XB_TMO])) break; if (sp > XB_SPIN_CAP) { atomicAdd(&bar[XB_TMO], 1u); break; } }
  }
  nloc = mine > 0u ? mine : 1u; nx = cnt > 0u ? cnt : 1u;
}
DI void xcd_barrier(const XcdBarrier& b) {
  asm volatile("s_waitcnt vmcnt(0)" ::: "memory");
  __syncthreads();
  if (threadIdx.x == 0) {
    unsigned* bar = b.bar;
    __builtin_amdgcn_s_waitcnt(0);
    unsigned nloc = b.st[0], nx = b.st[1];
    if (nloc == 0u) { xcd_barrier_complete(bar, b.x, nloc, nx); b.st[0] = nloc; b.st[1] = nx; }
    const unsigned old = xb_add(&bar[XB_XSUB(b.x)], 1u);
    const unsigned gen = old / nloc;
    if (old + 1u == (gen + 1u) * nloc) {
      __builtin_amdgcn_fence(__ATOMIC_RELEASE, "agent");
      asm volatile("s_waitcnt vmcnt(0)" ::: "memory");
      const unsigned og = xb_add(&bar[XB_TOP], 1u);
      const unsigned tg = og / nx;
      if (og + 1u == (tg + 1u) * nx) xb_add(&bar[XB_TOPGEN], 1u);
      else XB_SPIN(xb_ld(&bar[XB_TOPGEN]) == tg, bar);
      __builtin_amdgcn_fence(__ATOMIC_ACQUIRE, "agent");
      xb_add(&bar[XB_XGEN(b.x)], 1u);
      asm volatile("s_waitcnt vmcnt(0)" ::: "memory");
    } else {
      XB_SPIN(xb_ld(&bar[XB_XGEN(b.x)]) == gen, bar);
      __builtin_amdgcn_fence(__ATOMIC_ACQUIRE, "agent");
      asm volatile("s_waitcnt vmcnt(0)" ::: "memory");
    }
  }
  __syncthreads();
}

__shared__ int s_vb;
__shared__ uint4 xb_words;
__global__ void __launch_bounds__(256, 2) fwd_megakernel(Params p) {
  __shared__ __attribute__((aligned(16))) char smem[SMEM_BYTES];
  if (p.bar == nullptr) cg::this_grid().sync();
  if (threadIdx.x == 0) xb_words = make_uint4(0u, 0u, 0u, 0u);
  __syncthreads();
  XcdBarrier xb = xcd_barrier_post(p.bar, (volatile LAS unsigned*)&xb_words);
  int xloc = 0;
  if (threadIdx.x == 0) xloc = atomicAdd(p.ctr + 16 + (int)(xb.x & 7u), 1);
  run_phase<0>(p, smem, blockIdx.x); xcd_barrier(xb);
#if defined(REP_PHASE) && REP_PHASE == 0
  run_phase<0>(p, smem, blockIdx.x); xcd_barrier(xb);
#endif
  if (threadIdx.x == 0) {
    bool even = (gridDim.x & 7) == 0;
    for (int i = 0; i < 8; ++i) even = even && (__hip_atomic_load(p.ctr + 16 + i, __ATOMIC_RELAXED, __HIP_MEMORY_SCOPE_AGENT) == (int)(gridDim.x >> 3));
    s_vb = even ? xloc * 8 + (int)(xb.x & 7u) : (int)blockIdx.x;
  }
  __syncthreads();
  const int vb = s_vb;
  run_phase<1>(p, smem, vb); xcd_barrier(xb);
#if defined(REP_PHASE) && REP_PHASE == 1
  run_phase<1>(p, smem, vb, 8); xcd_barrier(xb);
#endif
  run_phase<2>(p, smem, vb); xcd_barrier(xb);
#if defined(REP_PHASE) && REP_PHASE == 2
  run_phase<2>(p, smem, vb, 8); xcd_barrier(xb);
#endif
  run_phase<3>(p, smem, vb); xcd_barrier(xb);
#if defined(REP_PHASE) && REP_PHASE == 3
  run_phase<3>(p, smem, vb, 8); xcd_barrier(xb);
#endif
  run_phase<4>(p, smem, vb); xcd_barrier(xb);
#if defined(REP_PHASE) && REP_PHASE == 4
  run_phase<4>(p, smem, vb, 8); xcd_barrier(xb);
#endif
  run_phase<5>(p, smem, vb); xcd_barrier(xb);
#if defined(REP_PHASE) && REP_PHASE == 5
  run_phase<5>(p, smem, vb, 8); xcd_barrier(xb);
#endif
  run_phase<6>(p, smem, vb); xcd_barrier(xb);
#if defined(REP_PHASE) && REP_PHASE == 6
  run_phase<6>(p, smem, vb, 8); xcd_barrier(xb);
#endif
  run_phase<7>(p, smem, vb); xcd_barrier(xb);
#if defined(REP_PHASE) && REP_PHASE == 7
  run_phase<7>(p, smem, vb, 8); xcd_barrier(xb);
#endif
  run_phase<8>(p, smem, vb); xcd_barrier(xb);
#if defined(REP_PHASE) && REP_PHASE == 8
  run_phase<8>(p, smem, vb, 8); xcd_barrier(xb);
#endif
  run_phase<9>(p, smem, vb);
}

extern "C" void kernel_launch(void* const* d_in, const int* in_sizes, int n_in, void* d_out, int out_size, void* d_ws, size_t ws_size, hipStream_t stream) {
  static int grid_blocks = 0;
  if (!grid_blocks) {
    int dev = 0, cus = 0, per_cu = 0;
    (void)hipGetDevice(&dev);
    (void)hipDeviceGetAttribute(&cus, hipDeviceAttributeMultiprocessorCount, dev);
    (void)hipOccupancyMaxActiveBlocksPerMultiprocessor(&per_cu, fwd_megakernel, 256, 0);
    if (per_cu < 1) per_cu = 1;
    if (per_cu > 2) per_cu = 2;
    grid_blocks = cus * per_cu;
  }
  Params p{};
  const float* const* in = (const float* const*)d_in;
  p.x_prompt = in[0]; p.x_sample = in[1]; p.st_s5_re = in[2]; p.st_s5_im = in[3]; p.st_gdn = in[4]; p.st_gdn_conv = in[5]; p.st_ffn_conv = in[6];
  p.norm1_g = in[7]; p.w_in = in[8]; p.a_re = in[9]; p.a_im = in[10]; p.log_dt = in[11]; p.b_re = in[12]; p.b_im = in[13]; p.c_re = in[14]; p.c_im = in[15];
  p.s5_d = in[16]; p.w_glu = in[17]; p.gdn_conv_w = in[18]; p.a_log = in[19]; p.dt_bias = in[20]; p.onorm_g = in[21]; p.w_out = in[22]; p.norm2_g = in[23];
  p.w_up = in[24]; p.ffn_conv_w = in[25]; p.w_down = in[26]; p.normf_g = in[27];
  float* o = (float*)d_out;
  p.out = o;
  size_t off = (size_t)MROWS * 1024;
  p.p_s5_re = o + off; off += 8 * 32 * 64;
  p.p_s5_im = o + off; off += 8 * 32 * 64;
  p.p_gdn = o + off; off += (size_t)8 * 4 * 128 * 128;
  p.p_gdn_conv = o + off; off += 8 * 3 * 1536;
  p.p_ffn_conv = o + off; off += 8 * 2 * 5632;
  p.s_s5_re = o + off; off += 128 * 32 * 64;
  p.s_s5_im = o + off; off += 128 * 32 * 64;
  p.s_gdn = o + off; off += (size_t)128 * 4 * 128 * 128;
  p.s_gdn_conv = o + off; off += 128 * 3 * 1536;
  p.s_ffn_conv = o + off; off += 128 * 2 * 5632;
  p.ogdn = o;
  p.ys5 = (bf16_t*)(o + (size_t)NTOK * 512);
  char* ws = (char*)d_ws;
  size_t wo = 0;
  auto take = [&](size_t bytes) { char* r = ws + wo; wo += (bytes + 255) & ~(size_t)255; return r; };
  p.ctr = (int*)take(256);
  p.bar = (unsigned*)take(XCD_BAR_WORDS * 4);
  p.ba = (float*)take((size_t)MROWS * 8 * 4);
  p.glast = (float*)take(1024 * 4);
  p.sproj = (float*)take((size_t)128 * NPROJ * 4);
  p.WinT = (bf16_t*)take((size_t)2560 * 1024 * 2);
  p.WgluT = (bf16_t*)take((size_t)1024 * 512 * 2);
  p.WoutT = (bf16_t*)take((size_t)1024 * 1024 * 2);
  p.WupT = (bf16_t*)take((size_t)5632 * 1024 * 2);
  p.WdnT = (bf16_t*)take((size_t)1024 * 2816 * 2);
  p.XN = (bf16_t*)take((size_t)MROWS * 1024 * 2);
  p.PROJ = (bf16_t*)take((size_t)MROWS * NPROJ * 2);
  p.ACT = p.PROJ;
  p.GDNI = (bf16_t*)take((size_t)1024 * 36864 * 2);
  if (wo > ws_size) { fprintf(stderr, "workspace too small: need %zu have %zu\n", wo, ws_size); return; }
  (void)hipMemsetAsync(p.ctr, 0, 256 + ((XCD_BAR_WORDS * 4 + 255) & ~255), stream);
#if MK_MULTI
  phase_kernel<0><<<grid_blocks, 256, 0, stream>>>(p);
  phase_kernel<1><<<grid_blocks, 256, 0, stream>>>(p);
  phase_kernel<2><<<grid_blocks, 256, 0, stream>>>(p);
  phase_kernel<3><<<grid_blocks, 256, 0, stream>>>(p);
  phase_kernel<4><<<grid_blocks, 256, 0, stream>>>(p);
  phase_kernel<5><<<grid_blocks, 256, 0, stream>>>(p);
  phase_kernel<6><<<grid_blocks, 256, 0, stream>>>(p);
  phase_kernel<7><<<grid_blocks, 256, 0, stream>>>(p);
  phase_kernel<8><<<grid_blocks, 256, 0, stream>>>(p);
  phase_kernel<9><<<grid_blocks, 256, 0, stream>>>(p);
#else
  void* args[] = {&p};
  hipError_t e = hipLaunchCooperativeKernel((void*)fwd_megakernel, dim3(grid_blocks), dim3(256), args, 0, stream);
  if (e != hipSuccess) fprintf(stderr, "cooperative launch failed: %s (grid %d)\n", hipGetErrorString(e), grid_blocks);
#endif
}
```
